# Optimizing an MI355X kernel written in HIP

```python
import math
import jax
import jax.numpy as jnp
from jax import lax
import numpy as np

D_MODEL = 1024
BATCH = 8
SEQ = 4096
DEPTH = 4

SSD_HEADS = 16
SSD_HEAD_DIM = 64
SSD_INNER = SSD_HEADS * SSD_HEAD_DIM
SSD_GROUPS = 2
SSD_STATE = 128
SSD_CONV_DIM = SSD_INNER + 2 * SSD_GROUPS * SSD_STATE
CONV_WIDTH = 4
SSD_CHUNK = 128
ATT_HEADS = 8
ATT_KV_HEADS = 2
ATT_HEAD_DIM = 64
ATT_WIDTH = ATT_HEADS * ATT_HEAD_DIM
IDX_HEADS = 4
IDX_HEAD_DIM = 64
TOPK_MAX = 256
Q_BLOCK = 128
POOL_WINDOWS = (2, 4, 8, 16)
POOL_GROUPS = 4
POOL_GROUP_DIM = 128
POOL_WIDTH = POOL_GROUPS * POOL_GROUP_DIM
N_BRANCH = 3
FFN_HIDDEN = ((8 * D_MODEL // 3 + 255) // 256) * 256
EPS = 1e-6
IN_SIZES = (SSD_INNER, SSD_CONV_DIM, SSD_HEADS, ATT_WIDTH, ATT_KV_HEADS * ATT_HEAD_DIM, ATT_KV_HEADS * ATT_HEAD_DIM, IDX_HEADS * IDX_HEAD_DIM, IDX_HEAD_DIM, IDX_HEADS, POOL_WIDTH, N_BRANCH * D_MODEL)
IN_WIDTH = SSD_INNER + SSD_CONV_DIM + SSD_HEADS + ATT_WIDTH + 2 * ATT_KV_HEADS * ATT_HEAD_DIM + IDX_HEADS * IDX_HEAD_DIM + IDX_HEAD_DIM + IDX_HEADS + POOL_WIDTH + N_BRANCH * D_MODEL

kernel_name = "hybrid_ssd_dsa_pool_gated_block"


def _rmsnorm(x, w):
    xf = x.astype(jnp.float32)
    y = xf * lax.rsqrt(jnp.mean(xf * xf, axis=-1, keepdims=True) + EPS)
    return (y * w.astype(jnp.float32)).astype(x.dtype)


def _split_proj(p):
    offs, acc = [], 0
    for s in IN_SIZES[:-1]:
        acc += s
        offs.append(acc)
    return jnp.split(p, offs, axis=-1)


def _causal_dwconv(u, w, b):
    out = lax.conv_general_dilated(u, w[:, None, :].astype(u.dtype), window_strides=(1,), padding=[(CONV_WIDTH - 1, 0)], dimension_numbers=('NWC', 'WIO', 'NWC'), feature_group_count=u.shape[-1])
    return out + b.astype(u.dtype)


def _ssd_scan(xh, dt, A, Bm, Cm):
    out_dtype = xh.dtype
    b, T, g, j, p = xh.shape
    n = Bm.shape[-1]
    c = T // SSD_CHUNK
    f32 = jnp.float32
    x = (xh.astype(f32) * dt.astype(f32)[..., None]).reshape(b, c, SSD_CHUNK, g, j, p)
    a = (dt.astype(f32) * A.astype(f32)).reshape(b, c, SSD_CHUNK, g, j)
    Bc = Bm.astype(f32).reshape(b, c, SSD_CHUNK, g, n)
    Cc = Cm.astype(f32).reshape(b, c, SSD_CHUNK, g, n)
    a_cs = jnp.cumsum(a, axis=2)
    causal = jnp.tril(jnp.ones((SSD_CHUNK, SSD_CHUNK), dtype=bool))[None, None, :, :, None, None]
    seg = a_cs[:, :, :, None] - a_cs[:, :, None, :]
    lmat = jnp.exp(jnp.where(causal, seg, -jnp.inf))
    cb = jnp.einsum('bclgn,bcsgn->bclsg', Cc, Bc)
    y_diag = jnp.einsum('bclsg,bclsgj,bcsgjp->bclgjp', cb, lmat, x)
    decay_states = jnp.exp(a_cs[:, :, -1:] - a_cs)
    states = jnp.einsum('bclgn,bclgj,bclgjp->bcgjpn', Bc, decay_states, x)
    chunk_decay = jnp.exp(a_cs[:, :, -1])

    def step(h, inp):
        s_c, d_c = inp
        return h * d_c[..., None, None] + s_c, h

    h0 = jnp.zeros((b, g, j, p, n), f32)
    _, prev = lax.scan(step, h0, (jnp.swapaxes(states, 0, 1), jnp.swapaxes(chunk_decay, 0, 1)))
    prev = jnp.swapaxes(prev, 0, 1)
    y_off = jnp.einsum('bclgn,bcgjpn,bclgj->bclgjp', Cc, prev, jnp.exp(a_cs))
    return (y_diag + y_off).reshape(b, T, g, j, p).astype(out_dtype)


def _dsa_attention(q, k, v, qi, ki, wi):
    b, T = q.shape[0], q.shape[1]
    topk = min(TOPK_MAX, T // 4)
    nb = T // Q_BLOCK
    att_scale = ATT_HEAD_DIM ** -0.5
    idx_scale = (IDX_HEADS ** -0.5) * (IDX_HEAD_DIM ** -0.5)
    key_pos = jnp.arange(T)
    ki32 = ki.astype(jnp.float32)

    def blockify(a):
        return jnp.swapaxes(a.reshape((b, nb, Q_BLOCK) + a.shape[2:]), 0, 1)

    def one_block(args):
        qb, qib, wib, pos = args
        s = jnp.einsum('bqhd,bsd->bqhs', qib.astype(jnp.float32), ki32)
        score = jnp.einsum('bqhs,bqh->bqs', jax.nn.relu(s), wib.astype(jnp.float32) * idx_scale)
        admissible = key_pos[None, None, :] <= pos[None, :, None]
        score = jnp.where(admissible, score, -jnp.inf)
        _, idx = lax.top_k(score, topk)
        valid = idx <= pos[None, :, None]
        ksel = jax.vmap(lambda kb, ib: kb[ib])(k, idx)
        vsel = jax.vmap(lambda vb, ib: vb[ib])(v, idx)
        logits = jnp.einsum('bqhgd,bqkhd->bqhgk', qb, ksel).astype(jnp.float32) * att_scale
        logits = jnp.where(valid[:, :, None, None, :], logits, -jnp.inf)
        prob = jax.nn.softmax(logits, axis=-1)
        return jnp.einsum('bqhgk,bqkhd->bqhgd', prob.astype(vsel.dtype), vsel)

    pos_blocks = jnp.arange(T).reshape(nb, Q_BLOCK)
    out = lax.map(one_block, (blockify(q), blockify(qi), blockify(wi), pos_blocks))
    return jnp.swapaxes(out, 0, 1).reshape(b, T, ATT_WIDTH)


def _pool_mixer(u, w, scale):
    b, T, _ = u.shape
    ug = u.reshape(b, T, POOL_GROUPS, POOL_GROUP_DIM).astype(jnp.float32)
    cs = jnp.cumsum(ug, axis=1)
    t1 = jnp.arange(1, T + 1, dtype=jnp.float32)
    outs = []
    for gi, win in enumerate(POOL_WINDOWS):
        c = cs[:, :, gi]
        lag = jnp.pad(c, ((0, 0), (win, 0), (0, 0)))[:, :T]
        cnt = jnp.minimum(t1, float(win))[None, :, None]
        outs.append((c - lag) / cnt - ug[:, :, gi])
    pooled = jnp.stack(outs, axis=2).astype(u.dtype)
    mixed = jnp.einsum('btgc,gcd->btgd', pooled, w)
    return mixed.reshape(b, T, POOL_WIDTH) * scale


def _layer(h, norm1_w, w_in, conv_w, conv_b, dt_bias, a_log, d_skip, ssd_norm_w, pool_w, pool_scale, w_up_ssd, w_up_attn, w_up_pool, w_out, norm2_w, w_ffn_in, w_ffn_out):
    b, T, _ = h.shape
    xn = _rmsnorm(h, norm1_w)
    proj = xn @ w_in
    z, xbc, dt_raw, q, k, v, qi, ki, wi, u, gates = _split_proj(proj)
    xbc = jax.nn.silu(_causal_dwconv(xbc, conv_w, conv_b))
    xs, Bm, Cm = jnp.split(xbc, [SSD_INNER, SSD_INNER + SSD_GROUPS * SSD_STATE], axis=-1)
    dt = jax.nn.softplus(dt_raw + dt_bias)
    A = -jnp.exp(a_log)
    hpg = SSD_HEADS // SSD_GROUPS
    xh = xs.reshape(b, T, SSD_GROUPS, hpg, SSD_HEAD_DIM)
    y = _ssd_scan(xh, dt.reshape(b, T, SSD_GROUPS, hpg), A.reshape(SSD_GROUPS, hpg), Bm.reshape(b, T, SSD_GROUPS, SSD_STATE), Cm.reshape(b, T, SSD_GROUPS, SSD_STATE))
    y = y + d_skip.reshape(SSD_GROUPS, hpg)[..., None] * xh
    y_ssd = _rmsnorm(y.reshape(b, T, SSD_INNER) * jax.nn.silu(z), ssd_norm_w)
    qh = q.reshape(b, T, ATT_KV_HEADS, ATT_HEADS // ATT_KV_HEADS, ATT_HEAD_DIM)
    kh = k.reshape(b, T, ATT_KV_HEADS, ATT_HEAD_DIM)
    vh = v.reshape(b, T, ATT_KV_HEADS, ATT_HEAD_DIM)
    y_att = _dsa_attention(qh, kh, vh, qi.reshape(b, T, IDX_HEADS, IDX_HEAD_DIM), ki, wi)
    y_pool = _pool_mixer(u, pool_w, pool_scale)
    g = jax.nn.sigmoid(gates.reshape(b, T, N_BRANCH, D_MODEL))
    merged = g[:, :, 0] * (y_ssd @ w_up_ssd) + g[:, :, 1] * (y_att @ w_up_attn) + g[:, :, 2] * (y_pool @ w_up_pool)
    h = h + merged @ w_out
    hn = _rmsnorm(h, norm2_w)
    a_part, b_part = jnp.split(hn @ w_ffn_in, 2, axis=-1)
    return h + (jax.nn.silu(a_part) * b_part) @ w_ffn_out


def setup_inputs(seed: int = 0) -> dict:
    key = jax.random.key(seed)
    ks = jax.random.split(key, 20)
    f32 = jnp.float32
    L = DEPTH

    def nrm(k, shape, fan_in):
        return jax.random.normal(k, shape, f32) * (fan_in ** -0.5)

    def gain(k, shape):
        return 1.0 + 0.02 * jax.random.normal(k, shape, f32)

    u_dt = jax.random.uniform(ks[5], (L, SSD_HEADS), f32)
    dt0 = jnp.exp(u_dt * (math.log(0.1) - math.log(0.001)) + math.log(0.001))
    dt_bias = dt0 + jnp.log(-jnp.expm1(-dt0))
    return {
        "x": jax.random.normal(ks[0], (BATCH, SEQ, D_MODEL), f32),
        "norm1_w": gain(ks[1], (L, D_MODEL)),
        "w_in": nrm(ks[2], (L, D_MODEL, IN_WIDTH), D_MODEL),
        "conv_w": nrm(ks[3], (L, CONV_WIDTH, SSD_CONV_DIM), CONV_WIDTH),
        "conv_b": 0.02 * jax.random.normal(ks[4], (L, SSD_CONV_DIM), f32),
        "dt_bias": dt_bias,
        "a_log": jnp.log(jax.random.uniform(ks[6], (L, SSD_HEADS), f32, minval=1.0, maxval=16.0)),
        "d_skip": gain(ks[7], (L, SSD_HEADS)),
        "ssd_norm_w": gain(ks[8], (L, SSD_INNER)),
        "pool_w": nrm(ks[9], (L, POOL_GROUPS, POOL_GROUP_DIM, POOL_GROUP_DIM), POOL_GROUP_DIM),
        "pool_scale": gain(ks[10], (L, POOL_WIDTH)),
        "w_up_ssd": nrm(ks[11], (L, SSD_INNER, D_MODEL), SSD_INNER),
        "w_up_attn": nrm(ks[12], (L, ATT_WIDTH, D_MODEL), ATT_WIDTH),
        "w_up_pool": nrm(ks[13], (L, POOL_WIDTH, D_MODEL), POOL_WIDTH),
        "w_out": nrm(ks[14], (L, D_MODEL, D_MODEL), D_MODEL),
        "norm2_w": gain(ks[15], (L, D_MODEL)),
        "w_ffn_in": nrm(ks[16], (L, D_MODEL, 2 * FFN_HIDDEN), D_MODEL),
        "w_ffn_out": nrm(ks[17], (L, FFN_HIDDEN, D_MODEL), FFN_HIDDEN),
        "final_norm_w": gain(ks[18], (D_MODEL,)),
    }


def reference(x, norm1_w, w_in, conv_w, conv_b, dt_bias, a_log, d_skip, ssd_norm_w, pool_w, pool_scale, w_up_ssd, w_up_attn, w_up_pool, w_out, norm2_w, w_ffn_in, w_ffn_out, final_norm_w):
    h = x
    for l in range(DEPTH):
        h = _layer(h, norm1_w[l], w_in[l], conv_w[l], conv_b[l], dt_bias[l], a_log[l], d_skip[l], ssd_norm_w[l], pool_w[l], pool_scale[l], w_up_ssd[l], w_up_attn[l], w_up_pool[l], w_out[l], norm2_w[l], w_ffn_in[l], w_ffn_out[l])
    return _rmsnorm(h, final_norm_w)
```

```cpp
#include <hip/hip_runtime.h>
#include <cstdio>
#include <cstdint>

constexpr int NB = 8, T = 4096, D = 1024, NL = 4, M = NB * T;
constexpr int NBP = 4, MP = NBP * T, NPASS = NB / NBP;
constexpr int INW = 7252, INW_PAD = 7424, FFH = 2816;
constexpr float EPS = 1e-6f;
constexpr size_t MiB = 1u << 20;
constexpr size_t WS_CTL = 0, CTL_ZERO_BYTES = 1 * MiB;
constexpr size_t WS_WIN = 2 * MiB, WS_WUS = 17 * MiB, WS_WUA = 19 * MiB, WS_WUP = 20 * MiB, WS_WOUT = 21 * MiB, WS_WFI = 23 * MiB, WS_WFO = 34 * MiB;
constexpr size_t WS_XN = 40 * MiB;
constexpr size_t WS_Z = 104 * MiB, WS_XBC = 136 * MiB, WS_Q = 184 * MiB, WS_KV = 200 * MiB, WS_QI = 208 * MiB, WS_U = 216 * MiB, WS_MISC = 232 * MiB,
                 WS_GATES = 240 * MiB, WS_XBCC = 336 * MiB, WS_POOLED = 384 * MiB, WS_MERGED = 400 * MiB, WS_END = 432 * MiB;
constexpr size_t WS_ACT = 104 * MiB;
static_assert(WS_ACT + (size_t)M * FFH * 2 <= WS_END, "ACT overlay");
namespace pg8 {
#define PG8_LAS __attribute__((address_space(3)))
typedef unsigned short bf16_t;
typedef short bf16x8 __attribute__((ext_vector_type(8)));
typedef float f32x4 __attribute__((ext_vector_type(4)));
typedef unsigned u32x4 __attribute__((ext_vector_type(4)));
constexpr int BM = 256, BK = 64, HALF = 128, HTB = HALF * BK * 2  , STAGE_BYTES = 8 * HTB, NXCD = 8, WGM = 8;

__host__ __device__ __forceinline__ int lds_byte(int r, int c) { const int st = (r >> 4) * 2 + (c >> 5), rr = r & 15, cc = c & 31, ob = rr * 64 + cc * 2; return st * 1024 + (ob ^ (((ob >> 9) & 1) << 5)); }
__host__ __device__ __forceinline__ void stage_rc(int b, int& R, int& C) { const int st = b / 1024, sb = b % 1024, swz = sb ^ (((sb >> 9) & 1) << 5); R = (st >> 1) * 16 + swz / 64; C = (st & 1) * 32 + (swz % 64) / 2; }
__host__ __device__ __forceinline__ int perm32(int rho) { const int n = rho >> 4, i = rho & 15; return 8 * (i >> 2) + 4 * n + (i & 3); }

struct Unit { int pm, pn; };
struct Gemm { const bf16_t* A; const bf16_t* Bt; int M, N, K; };

struct StaticOrder {
    int nM, nN, nwg, G, c;
    __host__ __device__ void init(int M, int N, int G_, int c_) { nM = M / BM; nN = N / BM; nwg = nM * nN; G = G_; c = c_; }
    __host__ __device__ bool next(int i, Unit& u) const {
        const long L = (long)i * G + c; if (L >= nwg) return false;
        int wgid = (int)L; { const int q = nwg / NXCD, r = nwg % NXCD, xcd = wgid % NXCD, off = wgid / NXCD; wgid = (xcd < r ? xcd * (q + 1) : r * (q + 1) + (xcd - r) * q) + off; }
        const int nig = WGM * nN, gid = wgid / nig, fm = gid * WGM, gsz = (nM - fm) < WGM ? (nM - fm) : WGM;
        u.pm = fm + ((wgid % nig) % gsz); u.pn = (wgid % nig) / gsz; return true;
    }
    __device__ __forceinline__ void a_ready(const Unit&) const {}
    __device__ __forceinline__ void done(const Unit&) const {}
};

__device__ __forceinline__ unsigned cvt_pk_bf16(float lo, float hi) { unsigned r; asm volatile("v_cvt_pk_bf16_f32 %0, %1, %2" : "=v"(r) : "v"(lo), "v"(hi)); return r; }
typedef float f32x2 __attribute__((ext_vector_type(2)));
__device__ __forceinline__ float bf_lo(unsigned w) { return __uint_as_float(w << 16); }
__device__ __forceinline__ float bf_hi(unsigned w) { return __uint_as_float(w & 0xffff0000u); }
__device__ __forceinline__ float sigm(float x) { return 1.0f / (1.0f + __expf(-x)); }

struct EpiProj {
    static constexpr bool PERM = true, AFTER_DRAIN = false;
    unsigned char* ws;
    __device__ __forceinline__ void operator()(const f32x4 (&acc)[2][2][4][2], const Unit& u, int wr, int wc, int fr, int fq) const {
        const int pn = u.pn; size_t off; int ldc, c0;
        if (pn < 4)       { off = WS_Z;     ldc = 1024; c0 = pn * 256; }
        else if (pn < 10) { off = WS_XBC;   ldc = 1536; c0 = (pn - 4) * 256; }
        else if (pn < 12) { off = WS_Q;     ldc = 512;  c0 = (pn - 10) * 256; }
        else if (pn < 13) { off = WS_KV;    ldc = 256;  c0 = 0; }
        else if (pn < 14) { off = WS_QI;    ldc = 256;  c0 = 0; }
        else if (pn < 16) { off = WS_U;     ldc = 512;  c0 = (pn - 14) * 256; }
        else if (pn < 28) { off = WS_GATES; ldc = 3072; c0 = (pn - 16) * 256; }
        else              { off = WS_MISC;  ldc = 256;  c0 = 0; }
        bf16_t* base = (bf16_t*)(ws + off);
        const int row0 = u.pm * BM + wr * 64 + fr, col0 = c0 + wc * 32 + 8 * fq;
#pragma unroll
        for (int ai = 0; ai < 2; ++ai)
#pragma unroll
            for (int m = 0; m < 4; ++m) { bf16_t* rowp = base + (size_t)(row0 + ai * HALF + m * 16) * ldc + col0;
#pragma unroll
                for (int bj = 0; bj < 2; ++bj) { const f32x4 v0 = acc[ai][bj][m][0], v1 = acc[ai][bj][m][1];
                    u32x4 w; w.x = cvt_pk_bf16(v0[0], v0[1]); w.y = cvt_pk_bf16(v0[2], v0[3]); w.z = cvt_pk_bf16(v1[0], v1[1]); w.w = cvt_pk_bf16(v1[2], v1[3]);
                    *(u32x4*)(rowp + bj * HALF) = w; } }
    }
};
struct EpiSwiGLU {
    static constexpr bool PERM = true, AFTER_DRAIN = false;
    bf16_t* O; int ldc;
    __device__ __forceinline__ void operator()(const f32x4 (&acc)[2][2][4][2], const Unit& u, int wr, int wc, int fr, int fq) const {
        const int row0 = u.pm * BM + wr * 64 + fr, col0 = u.pn * HALF + wc * 32 + 8 * fq;
#pragma unroll
        for (int ai = 0; ai < 2; ++ai)
#pragma unroll
            for (int m = 0; m < 4; ++m) { bf16_t* rowp = O + (size_t)(row0 + ai * HALF + m * 16) * ldc + col0;
                float r[8];
#pragma unroll
                for (int n = 0; n < 2; ++n)
#pragma unroll
                    for (int i = 0; i < 4; ++i) { const float a = acc[ai][0][m][n][i], b = acc[ai][1][m][n][i]; r[n * 4 + i] = a * sigm(a) * b; }
                u32x4 w; w.x = cvt_pk_bf16(r[0], r[1]); w.y = cvt_pk_bf16(r[2], r[3]); w.z = cvt_pk_bf16(r[4], r[5]); w.w = cvt_pk_bf16(r[6], r[7]);
                *(u32x4*)rowp = w; }
    }
};
struct EpiResid {
    static constexpr bool PERM = false, AFTER_DRAIN = false;
    const float* hin; float* out; int ldc;
    __device__ __forceinline__ void operator()(const f32x4 (&acc)[2][2][4][2], const Unit& u, int wr, int wc, int fr, int fq) const {
        const int row0 = u.pm * BM + wr * 64 + fr, col0 = u.pn * BM + wc * 32 + 4 * fq;
#pragma unroll
        for (int ai = 0; ai < 2; ++ai)
#pragma unroll
            for (int m = 0; m < 4; ++m) { const size_t off = (size_t)(row0 + ai * HALF + m * 16) * ldc + col0;
#pragma unroll
                for (int bj = 0; bj < 2; ++bj)
#pragma unroll
                    for (int n = 0; n < 2; ++n) { const f32x4 b = *(const f32x4*)(hin + off + bj * HALF + n * 16); *(f32x4*)(out + off + bj * HALF + n * 16) = b + acc[ai][bj][m][n]; }
                if (m & 1) asm volatile("" ::: "memory"); }
    }
};
template <bool FIRST> struct EpiMerge {
    static constexpr bool PERM = true, AFTER_DRAIN = false;
    const bf16_t* gates; bf16_t* P;
    __device__ __forceinline__ void operator()(const f32x4 (&acc)[2][2][4][2], const Unit& u, int wr, int wc, int fr, int fq) const {
        const int row0 = u.pm * BM + wr * 64 + fr, col0 = u.pn * BM + wc * 32 + 8 * fq;
#pragma unroll
        for (int ai = 0; ai < 2; ++ai)
#pragma unroll
            for (int m = 0; m < 4; ++m) { const size_t row = (size_t)(row0 + ai * HALF + m * 16);
#pragma unroll
                for (int bj = 0; bj < 2; ++bj) { const int c = col0 + bj * HALF;
                    const u32x4 gw = *(const u32x4*)(gates + row * 3072 + c);
                    const f32x4 v0 = acc[ai][bj][m][0], v1 = acc[ai][bj][m][1];
                    float r[8];
                    r[0] = sigm(bf_lo(gw.x)) * v0[0]; r[1] = sigm(bf_hi(gw.x)) * v0[1]; r[2] = sigm(bf_lo(gw.y)) * v0[2]; r[3] = sigm(bf_hi(gw.y)) * v0[3];
                    r[4] = sigm(bf_lo(gw.z)) * v1[0]; r[5] = sigm(bf_hi(gw.z)) * v1[1]; r[6] = sigm(bf_lo(gw.w)) * v1[2]; r[7] = sigm(bf_hi(gw.w)) * v1[3];
                    if (!FIRST) { const u32x4 pw = *(const u32x4*)(P + row * 1024 + c);
                        r[0] += bf_lo(pw.x); r[1] += bf_hi(pw.x); r[2] += bf_lo(pw.y); r[3] += bf_hi(pw.y); r[4] += bf_lo(pw.z); r[5] += bf_hi(pw.z); r[6] += bf_lo(pw.w); r[7] += bf_hi(pw.w); }
                    u32x4 w; w.x = cvt_pk_bf16(r[0], r[1]); w.y = cvt_pk_bf16(r[2], r[3]); w.z = cvt_pk_bf16(r[4], r[5]); w.w = cvt_pk_bf16(r[6], r[7]);
                    *(u32x4*)(P + row * 1024 + c) = w; }
                asm volatile("" ::: "memory"); }
    }
};

template <class Epi, class Sched, bool ALIGN_EPI = false, bool SP2 = false>
__device__ __forceinline__ void gemm_phase(PG8_LAS unsigned char* lds, const Gemm g, const Sched& S, const Epi& E) {
    int tid_ = threadIdx.x; asm volatile("" : "+v"(tid_));
    const int tid = tid_, wid = __builtin_amdgcn_readfirstlane(tid >> 6), lane = tid & 63, wr = wid >> 2, wc = wid & 3, fr = lane & 15, fq = lane >> 4;
    const int K = g.K, nt = K / BK;
    unsigned voffA[2], voffB[2];
#pragma unroll
    for (int i = 0; i < 2; ++i) { int R, C; stage_rc(tid * 16 + i * 8192, R, C); const int Rb = Epi::PERM ? ((R & ~31) + perm32(R & 31)) : R;
        voffA[i] = (unsigned)(R * K + C) * 2u; voffB[i] = (unsigned)(Rb * K + C) * 2u; }
    const size_t kstep = (size_t)(BK * 2);
    const size_t hstep = (size_t)HALF * K * 2;
    const size_t tstep = 2 * hstep;
    const unsigned ldsw = (unsigned)wid * 1024u;
    const int aoff = lds_byte(wr * 64 + fr, fq * 8), boff = lds_byte(wc * 32 + fr, fq * 8);
#define PG8_SA(b, h) (((b) * 2 + (h)) * HTB)
#define PG8_SB(b, h) ((4 + (b) * 2 + (h)) * HTB)
#define PG8_STAGE(bufoff, gbase, voff) do { _Pragma("unroll") for (int _i = 0; _i < 2; ++_i) \
        __builtin_amdgcn_global_load_lds((const unsigned*)((const char*)(gbase) + (voff)[_i]), (PG8_LAS unsigned*)(lds + (bufoff) + ldsw + _i * 8192), 16, 0, 0); } while (0)
#define PG8_LDA(dst, b, h) do { _Pragma("unroll") for (int m = 0; m < 4; ++m) _Pragma("unroll") for (int k = 0; k < 2; ++k) dst[m][k] = *(const PG8_LAS bf16x8*)(lds + PG8_SA(b, h) + aoff + m * 2048 + k * 1024); } while (0)
#define PG8_LDB(dst, b, h) do { _Pragma("unroll") for (int n = 0; n < 2; ++n) _Pragma("unroll") for (int k = 0; k < 2; ++k) dst[n][k] = *(const PG8_LAS bf16x8*)(lds + PG8_SB(b, h) + boff + n * 2048 + k * 1024); } while (0)
#define PG8_MMA(ai, bj, At, Bt) do { __builtin_amdgcn_s_setprio(1); _Pragma("unroll") for (int m = 0; m < 4; ++m) _Pragma("unroll") for (int n = 0; n < 2; ++n) _Pragma("unroll") for (int k = 0; k < 2; ++k) \
        acc[ai][bj][m][n] = __builtin_amdgcn_mfma_f32_16x16x32_bf16(Bt[n][k], At[m][k], acc[ai][bj][m][n], 0, 0, 0); __builtin_amdgcn_s_setprio(0); } while (0)
#define PG8_WAIT_V(n) asm volatile("s_waitcnt vmcnt(" #n ")" ::: "memory")
#define PG8_WAIT_L(n) asm volatile("s_waitcnt lgkmcnt(" #n ")" ::: "memory")
#define PG8_BAR __builtin_amdgcn_s_barrier()
#define PG8_SCHED __builtin_amdgcn_sched_barrier(0)
    Unit cur, nxt; int ui = 0;
    if (!S.next(0, cur)) return;
    f32x4 acc[2][2][4][2];
#pragma unroll
    for (int a = 0; a < 2; ++a)
#pragma unroll
        for (int b = 0; b < 2; ++b)
#pragma unroll
            for (int m = 0; m < 4; ++m)
#pragma unroll
                for (int n = 0; n < 2; ++n) acc[a][b][m][n] = (f32x4){0.f, 0.f, 0.f, 0.f};
    bf16x8 At[4][2], B0[2][2], B1[2][2];
    const char* cA = (const char*)g.A + (size_t)cur.pm * tstep; const char* cB = (const char*)g.Bt + (size_t)cur.pn * tstep;
    S.a_ready(cur);
    if constexpr (SP2) {
        PG8_STAGE(PG8_SB(0, 0), cB, voffB); PG8_STAGE(PG8_SB(0, 1), cB + hstep, voffB); PG8_STAGE(PG8_SA(0, 0), cA, voffA); PG8_STAGE(PG8_SA(0, 1), cA + hstep, voffA);
        if (wr == 1) PG8_BAR;
        PG8_WAIT_V(2); PG8_BAR;
        PG8_STAGE(PG8_SB(1, 0), cB + kstep, voffB); PG8_STAGE(PG8_SA(1, 0), cA + kstep, voffA); PG8_STAGE(PG8_SB(1, 1), cB + hstep + kstep, voffB);
        PG8_WAIT_V(6); PG8_BAR;
    } else {
        PG8_STAGE(PG8_SB(0, 0), cB, voffB); PG8_STAGE(PG8_SA(0, 0), cA, voffA); PG8_STAGE(PG8_SB(0, 1), cB + hstep, voffB); PG8_STAGE(PG8_SA(0, 1), cA + hstep, voffA);
        if (wr == 1) PG8_BAR;
        PG8_WAIT_V(4); PG8_BAR;
        PG8_STAGE(PG8_SB(1, 0), cB + kstep, voffB); PG8_STAGE(PG8_SA(1, 0), cA + kstep, voffA); PG8_STAGE(PG8_SB(1, 1), cB + hstep + kstep, voffB);
        PG8_WAIT_V(6); PG8_BAR;
    }
    for (;;) {
        const bool has_next = S.next(ui + 1, nxt);
        const char* nA = has_next ? (const char*)g.A + (size_t)nxt.pm * tstep : cA; const char* nB = has_next ? (const char*)g.Bt + (size_t)nxt.pn * tstep : cB;
        for (int t = 0; t < nt; t += 2) {
            const bool last = (t == nt - 2);
            const char* a1 = cA + (size_t)(t + 1) * kstep;
            const char* a2 = last ? nA : cA + (size_t)(t + 2) * kstep; const char* b2 = last ? nB : cB + (size_t)(t + 2) * kstep;
            const char* a3 = a2 + kstep; const char* b3 = b2 + kstep;
            if (last && has_next) S.a_ready(nxt);
            if constexpr (SP2) {
            PG8_LDB(B0, 0, 0); PG8_LDB(B1, 0, 1); PG8_SCHED; PG8_LDA(At, 0, 0); PG8_STAGE(PG8_SA(1, 1), a1 + hstep, voffA);
            PG8_WAIT_V(8); PG8_WAIT_L(0); PG8_BAR; PG8_MMA(0, 0, At, B0); PG8_MMA(0, 1, At, B1); PG8_BAR; PG8_SCHED;
            PG8_LDA(At, 0, 1); PG8_STAGE(PG8_SB(0, 0), b2, voffB); PG8_STAGE(PG8_SB(0, 1), b2 + hstep, voffB); PG8_STAGE(PG8_SA(0, 0), a2, voffA);
            PG8_WAIT_V(8); PG8_WAIT_L(0); PG8_BAR; PG8_MMA(1, 0, At, B0); PG8_MMA(1, 1, At, B1); PG8_BAR; PG8_SCHED;
            PG8_LDB(B0, 1, 0); PG8_LDB(B1, 1, 1); PG8_SCHED; PG8_LDA(At, 1, 0); PG8_STAGE(PG8_SA(0, 1), a2 + hstep, voffA);
            PG8_WAIT_V(8); PG8_WAIT_L(0); PG8_BAR; PG8_MMA(0, 0, At, B0); PG8_MMA(0, 1, At, B1); PG8_BAR; PG8_SCHED;
            PG8_LDA(At, 1, 1); PG8_STAGE(PG8_SB(1, 0), b3, voffB); PG8_STAGE(PG8_SB(1, 1), b3 + hstep, voffB); PG8_STAGE(PG8_SA(1, 0), a3, voffA);
            PG8_WAIT_V(8); PG8_WAIT_L(0); PG8_BAR; PG8_MMA(1, 0, At, B0); PG8_MMA(1, 1, At, B1); PG8_BAR; PG8_SCHED;
            } else {
            PG8_LDB(B0, 0, 0); PG8_SCHED; PG8_LDA(At, 0, 0); PG8_STAGE(PG8_SA(1, 1), a1 + hstep, voffA);
            PG8_WAIT_L(8); PG8_BAR; PG8_WAIT_L(0); PG8_MMA(0, 0, At, B0); PG8_BAR; PG8_SCHED;
            PG8_LDB(B1, 0, 1); PG8_STAGE(PG8_SB(0, 0), b2, voffB);
            PG8_BAR; PG8_WAIT_L(0); PG8_MMA(0, 1, At, B1); PG8_BAR;
            PG8_LDA(At, 0, 1); PG8_STAGE(PG8_SA(0, 0), a2, voffA);
            PG8_BAR; PG8_WAIT_L(0); PG8_MMA(1, 0, At, B0); PG8_BAR; PG8_SCHED;
            PG8_STAGE(PG8_SB(0, 1), b2 + hstep, voffB);
            PG8_WAIT_V(6); PG8_BAR; PG8_MMA(1, 1, At, B1); PG8_BAR;
            PG8_LDB(B0, 1, 0); PG8_SCHED; PG8_LDA(At, 1, 0); PG8_STAGE(PG8_SA(0, 1), a2 + hstep, voffA);
            PG8_WAIT_L(8); PG8_BAR; PG8_WAIT_L(0); PG8_MMA(0, 0, At, B0); PG8_BAR; PG8_SCHED;
            PG8_LDB(B1, 1, 1); PG8_STAGE(PG8_SB(1, 0), b3, voffB);
            PG8_BAR; PG8_WAIT_L(0); PG8_MMA(0, 1, At, B1); PG8_BAR;
            PG8_LDA(At, 1, 1); PG8_STAGE(PG8_SA(1, 0), a3, voffA);
            PG8_BAR; PG8_WAIT_L(0); PG8_MMA(1, 0, At, B0); PG8_BAR; PG8_SCHED;
            PG8_STAGE(PG8_SB(1, 1), b3 + hstep, voffB);
            PG8_WAIT_V(6); PG8_BAR; PG8_MMA(1, 1, At, B1); PG8_BAR;
            }
        }
        if constexpr (ALIGN_EPI) { if (wr == 0) PG8_BAR; }
        if constexpr (!Epi::AFTER_DRAIN) { E(acc, cur, wr, wc, fr, fq); S.done(cur); }
        if (!has_next) break;
#pragma unroll
        for (int a = 0; a < 2; ++a)
#pragma unroll
            for (int b = 0; b < 2; ++b)
#pragma unroll
                for (int m = 0; m < 4; ++m)
#pragma unroll
                    for (int n = 0; n < 2; ++n) acc[a][b][m][n] = (f32x4){0.f, 0.f, 0.f, 0.f};
        cur = nxt; cA = nA; cB = nB; ++ui;
        if constexpr (ALIGN_EPI) { if (wr == 1) PG8_BAR; }
    }
    PG8_WAIT_V(0);
    if constexpr (!ALIGN_EPI) { if (wr == 0) PG8_BAR; }
    PG8_BAR;
    if constexpr (Epi::AFTER_DRAIN) { E.fused(acc, cur, wr, wc, fr, fq, lds, wid, lane); S.done(cur); }
#undef PG8_SA
#undef PG8_SB
#undef PG8_STAGE
#undef PG8_LDA
#undef PG8_LDB
#undef PG8_MMA
#undef PG8_WAIT_V
#undef PG8_WAIT_L
#undef PG8_BAR
#undef PG8_SCHED
}
}
#define GAS __attribute__((address_space(1)))
#define LAS __attribute__((address_space(3)))
typedef unsigned short bf16;
typedef unsigned v4u __attribute__((ext_vector_type(4)));
typedef float f32x4 __attribute__((ext_vector_type(4)));
typedef short bf16x8 __attribute__((ext_vector_type(8)));
typedef GAS unsigned gu32;
typedef GAS unsigned long long gu64;
#define RLX_AGENT __ATOMIC_RELAXED, __HIP_MEMORY_SCOPE_AGENT
#define LDS_WAIT() asm volatile("s_waitcnt lgkmcnt(0)" ::: "memory")
#define VM_WAIT() asm volatile("s_waitcnt vmcnt(0)" ::: "memory")
__device__ __forceinline__ unsigned long long rt() { return __builtin_amdgcn_s_memrealtime(); }
__device__ __forceinline__ unsigned f2bf(float f) { unsigned u = __builtin_bit_cast(unsigned, f); return (u + 0x7fffu + ((u >> 16) & 1u)) >> 16; }
__device__ __forceinline__ unsigned pk2(float lo, float hi) { return f2bf(lo) | (f2bf(hi) << 16); }

#define XB_TMO      128
#define XB_XCNT(j)  (256  + 64 * (j))
#define XB_XSUB(j)  (1280 + 64 * (j))
#define XB_XGEN(j)  (2304 + 64 * (j))
#define XB_TOP      3328
#define XB_TOPGEN   3392
#define XCD_BAR_WORDS 3456
#define XB_SPIN_CAP (1u << 18)

__device__ __forceinline__ unsigned xb_ld(unsigned* p)              { return __hip_atomic_load(p, __ATOMIC_RELAXED, __HIP_MEMORY_SCOPE_AGENT); }
__device__ __forceinline__ unsigned xb_add(unsigned* p, unsigned v) { return __hip_atomic_fetch_add(p, v, __ATOMIC_RELAXED, __HIP_MEMORY_SCOPE_AGENT); }
__device__ __forceinline__ unsigned xb_xcc_id() { return (unsigned)__builtin_amdgcn_s_getreg((3 << 11) | 20) & 0xFu; }
#define XB_SPIN(cond, bar) do { unsigned _sp = 0; while (cond) { __builtin_amdgcn_s_sleep(1); \
    if ((++_sp & 255u) == 0u) { if (xb_ld(&(bar)[XB_TMO])) break; if (_sp > XB_SPIN_CAP) { atomicAdd(&(bar)[XB_TMO], 1u); break; } } } } while (0)

struct XcdBarrier {
    unsigned* bar; unsigned x;
    volatile LAS unsigned* st;
};

__device__ __forceinline__ XcdBarrier xcd_barrier_post(unsigned* bar, volatile LAS unsigned* st) {
    XcdBarrier b; b.bar = bar; b.x = xb_xcc_id(); b.st = st;
    if (threadIdx.x == 0) (void)xb_add(&bar[XB_XCNT(b.x)], 1u);
    return b;
}
__device__ __forceinline__ void xcd_barrier_complete(unsigned* bar, unsigned x, unsigned& nloc, unsigned& nx) {
    const unsigned G = gridDim.x * gridDim.y * gridDim.z;
    unsigned sum, cnt, mine, sp = 0u;
    for (;;) {
        sum = 0u; cnt = 0u; mine = 0u;
#pragma unroll
        for (unsigned j = 0; j < 16; ++j) { const unsigned c = xb_ld(&bar[XB_XCNT(j)]); sum += c; cnt += (c > 0u) ? 1u : 0u; mine = (j == x) ? c : mine; }
        if (sum == G) break;
        __builtin_amdgcn_s_sleep(1);
        if ((++sp & 255u) == 0u) { if (xb_ld(&bar[XB_TMO])) break; if (sp > XB_SPIN_CAP) { atomicAdd(&bar[XB_TMO], 1u); break; } }
    }
    nloc = mine > 0u ? mine : 1u; nx = cnt > 0u ? cnt : 1u;
}

__device__ __forceinline__ void xcd_barrier(const XcdBarrier& b) {
    asm volatile("s_waitcnt vmcnt(0)" ::: "memory");
    __syncthreads();
    if (threadIdx.x == 0) {
        unsigned* bar = b.bar;
        __builtin_amdgcn_s_waitcnt(0);
        unsigned nloc = b.st[0], nx = b.st[1];
        if (nloc == 0u) { xcd_barrier_complete(bar, b.x, nloc, nx); b.st[0] = nloc; b.st[1] = nx; }
        const unsigned old = xb_add(&bar[XB_XSUB(b.x)], 1u);
        const unsigned gen = old / nloc;
        if (old + 1u == (gen + 1u) * nloc) {
            __builtin_amdgcn_fence(__ATOMIC_RELEASE, "agent");
            asm volatile("s_waitcnt vmcnt(0)" ::: "memory");
            const unsigned og = xb_add(&bar[XB_TOP], 1u);
            const unsigned tg = og / nx;
            if (og + 1u == (tg + 1u) * nx) xb_add(&bar[XB_TOPGEN], 1u);
            else XB_SPIN(xb_ld(&bar[XB_TOPGEN]) == tg, bar);
            __builtin_amdgcn_fence(__ATOMIC_ACQUIRE, "agent");
            xb_add(&bar[XB_XGEN(b.x)], 1u);
            asm volatile("s_waitcnt vmcnt(0)" ::: "memory");
        } else {
            XB_SPIN(xb_ld(&bar[XB_XGEN(b.x)]) == gen, bar);
            __builtin_amdgcn_fence(__ATOMIC_ACQUIRE, "agent");
            asm volatile("s_waitcnt vmcnt(0)" ::: "memory");
        }
    }
    __syncthreads();
}
constexpr int NWAVES = 8;
constexpr int RING_BYTES = 131072;
constexpr int LDSCTL_OFF = RING_BYTES, MISC_OFF = LDSCTL_OFF + 320;
constexpr int DSA_X_OFF = 132096;
constexpr int LDS_BYTES = 147456;
static_assert(MISC_OFF + 128 <= DSA_X_OFF && DSA_X_OFF + 8 * 1024 + 8 * 512 <= LDS_BYTES, "LDS map");
constexpr int NSTEPS = NL * 16 + 1;


struct Frame {
    LAS unsigned char* lds;
    volatile LAS unsigned* MISC;
    gu32* ctl;
    int tid, lane, wave, G, bid;
    unsigned char* ws;
};
__device__ __forceinline__ float bf2f(unsigned short b) { return __uint_as_float((unsigned)b << 16); }
__device__ __forceinline__ float wave_sum(float v) {
#pragma unroll
    for (int o = 32; o >= 1; o >>= 1) v += __shfl_xor(v, o);
    return v;
}
__device__ __forceinline__ float wave_max(float v) {
#pragma unroll
    for (int o = 32; o >= 1; o >>= 1) v = fmaxf(v, __shfl_xor(v, o));
    return v;
}
__device__ __forceinline__ float silu_f(float x) { return x / (1.0f + __expf(-x)); }
#define WAVE_LDS_FENCE() do { asm volatile("s_waitcnt lgkmcnt(0)" ::: "memory"); __builtin_amdgcn_wave_barrier(); asm volatile("" ::: "memory"); } while (0)

__device__ __forceinline__ int src_in(int r) {
    if (r < 2560) return r;
    if (r < 3072) return 2576 + (r - 2560);
    if (r < 3200) return 3088 + (r - 3072);
    if (r < 3328) return 3216 + (r - 3200);
    if (r < 3584) return 3344 + (r - 3328);
    if (r < 4096) return 3668 + (r - 3584);
    if (r < 7168) return 4180 + (r - 4096);
    if (r < 7232) return 3600 + (r - 7168);
    if (r < 7248) return 2560 + (r - 7232);
    if (r < 7252) return 3664 + (r - 7248);
    return -1;
}
__device__ __forceinline__ int src_ffi(int r) { const int t = r >> 8, w = r & 255; return w < 128 ? t * 128 + w : FFH + t * 128 + (w - 128); }
template <int MODE>
__device__ __forceinline__ void cvt_item(const float* W, int ldw, int K, int Ndst, bf16* WT, LAS float* scr, int item, int lane) {
    const int nblk = Ndst / 32, kb = item / nblk, nb = item % nblk, k0 = 64 * kb, r0 = 32 * nb;
    const int n = lane & 31;
    const int sc = MODE == 1 ? src_in(r0 + n) : MODE == 2 ? src_ffi(r0 + n) : r0 + n;
#pragma unroll 8
    for (int i = 0; i < 32; ++i) { const int kk = 2 * i + (lane >> 5); scr[kk * 33 + n] = sc >= 0 ? W[(size_t)(k0 + kk) * ldw + sc] : 0.f; }
    LDS_WAIT(); asm volatile("" ::: "memory");
    const int c = lane & 7;
#pragma unroll
    for (int j = 0; j < 4; ++j) { const int nn = (lane >> 3) + 8 * j; const LAS float* s = scr + (8 * c) * 33 + nn;
        v4u o; o.x = pk2(s[0 * 33], s[1 * 33]); o.y = pk2(s[2 * 33], s[3 * 33]); o.z = pk2(s[4 * 33], s[5 * 33]); o.w = pk2(s[6 * 33], s[7 * 33]);
        *(GAS v4u*)(WT + (size_t)(r0 + nn) * K + k0 + 8 * c) = o; }
    LDS_WAIT(); asm volatile("" ::: "memory");
}
struct LayerW { const float *w_in, *w_us, *w_ua, *w_up, *w_out, *w_fi, *w_fo, *pool_w, *pool_scale; };
__device__ __forceinline__ void phase_convert(Frame& F, const LayerW& W) {
    LAS float* scr = (LAS float*)(F.lds + F.wave * 16384);
    const int gw = F.bid * NWAVES + F.wave, NGW = F.G * NWAVES;
    constexpr int I_IN = (D / 64) * (INW_PAD / 32), I_US = (D / 64) * (D / 32), I_UA = (512 / 64) * (D / 32), I_OUT = I_US, I_FI = (D / 64) * (2 * FFH / 32), I_FO = (FFH / 64) * (D / 32);
    constexpr int NITEMS = I_IN + I_US + I_UA + I_OUT + I_FI + I_FO;
    for (int it = gw; it < NITEMS; it += NGW) {
        int r = it;
        if (r < I_IN) { cvt_item<1>(W.w_in, INW, D, INW_PAD, (bf16*)(F.ws + WS_WIN), scr, r, F.lane); continue; } r -= I_IN;
        if (r < I_US) { cvt_item<0>(W.w_us, D, D, D, (bf16*)(F.ws + WS_WUS), scr, r, F.lane); continue; } r -= I_US;
        if (r < I_UA) { cvt_item<0>(W.w_ua, D, 512, D, (bf16*)(F.ws + WS_WUA), scr, r, F.lane); continue; } r -= I_UA;
        if (r < I_OUT) { cvt_item<0>(W.w_out, D, D, D, (bf16*)(F.ws + WS_WOUT), scr, r, F.lane); continue; } r -= I_OUT;
        if (r < I_FI) { cvt_item<2>(W.w_fi, 2 * FFH, D, 2 * FFH, (bf16*)(F.ws + WS_WFI), scr, r, F.lane); continue; } r -= I_FI;
        cvt_item<0>(W.w_fo, D, FFH, D, (bf16*)(F.ws + WS_WFO), scr, r, F.lane);
    }
    bf16* WC = (bf16*)(F.ws + WS_WUP);
    for (int o = F.bid * (NWAVES * 64) + F.tid; o < 512 * 1024; o += F.G * NWAVES * 64) {
        const int n = o & 1023, kc = o >> 10, g = kc >> 7, c = kc & 127;
        const float* pw = W.pool_w + ((size_t)g * 128 + c) * 128; const float* ps = W.pool_scale + g * 128; const float* up = W.w_up + (size_t)(g * 128) * D + n;
        float s = 0.f;
        for (int d = 0; d < 128; ++d) s += pw[d] * ps[d] * up[(size_t)d * D];
        WC[(size_t)n * 512 + kc] = (bf16)f2bf(s);
    }
}
__device__ __forceinline__ void phase_norm_bf16(Frame& F, const float* src, const float* gain, bf16* dst, int nrows) {
    const int gw = F.bid * NWAVES + F.wave, NGW = F.G * NWAVES;
    f32x4 g[4];
#pragma unroll
    for (int j = 0; j < 4; ++j) g[j] = ((const f32x4*)gain)[F.lane + 64 * j];
    for (int m = gw; m < nrows; m += NGW) {
        const f32x4* xr = (const f32x4*)(src + (size_t)m * D) + F.lane;
        f32x4 v[4]; float s = 0.f;
#pragma unroll
        for (int j = 0; j < 4; ++j) { v[j] = xr[64 * j]; s += (v[j].x * v[j].x + v[j].y * v[j].y) + (v[j].z * v[j].z + v[j].w * v[j].w); }
        const float r = 1.0f / sqrtf(wave_sum(s) * (1.0f / D) + EPS);
        unsigned long long* o8 = (unsigned long long*)(dst + (size_t)m * D) + F.lane;
#pragma unroll
        for (int j = 0; j < 4; ++j) o8[64 * j] = (unsigned long long)pk2(v[j].x * r * g[j].x, v[j].y * r * g[j].y) | ((unsigned long long)pk2(v[j].z * r * g[j].z, v[j].w * r * g[j].w) << 32);
    }
}
__device__ __forceinline__ void phase_norm_f32_inplace(Frame& F, float* buf, const float* gain, int nrows) {
    const int gw = F.bid * NWAVES + F.wave, NGW = F.G * NWAVES;
    f32x4 g[4];
#pragma unroll
    for (int j = 0; j < 4; ++j) g[j] = ((const f32x4*)gain)[F.lane + 64 * j];
    for (int m = gw; m < nrows; m += NGW) {
        f32x4* xr = (f32x4*)(buf + (size_t)m * D) + F.lane;
        f32x4 v[4]; float s = 0.f;
#pragma unroll
        for (int j = 0; j < 4; ++j) { v[j] = xr[64 * j]; s += (v[j].x * v[j].x + v[j].y * v[j].y) + (v[j].z * v[j].z + v[j].w * v[j].w); }
        const float r = 1.0f / sqrtf(wave_sum(s) * (1.0f / D) + EPS);
#pragma unroll
        for (int j = 0; j < 4; ++j) xr[64 * j] = v[j] * r * g[j];
    }
}
__device__ __forceinline__ void phase_ssdnorm(Frame& F, bf16* Z, const float* gain) {
    const int gw = F.bid * NWAVES + F.wave, NGW = F.G * NWAVES;
    float g[16];
#pragma unroll
    for (int j = 0; j < 2; ++j)
#pragma unroll
        for (int i = 0; i < 8; ++i) g[j * 8 + i] = gain[j * 512 + F.lane * 8 + i];
    for (int m = gw; m < MP; m += NGW) {
        v4u* zr = (v4u*)(Z + (size_t)m * 1024);
        float v[16]; float s = 0.f;
#pragma unroll
        for (int j = 0; j < 2; ++j) { const v4u w = zr[j * 64 + F.lane];
            v[j * 8 + 0] = pg8::bf_lo(w.x); v[j * 8 + 1] = pg8::bf_hi(w.x); v[j * 8 + 2] = pg8::bf_lo(w.y); v[j * 8 + 3] = pg8::bf_hi(w.y);
            v[j * 8 + 4] = pg8::bf_lo(w.z); v[j * 8 + 5] = pg8::bf_hi(w.z); v[j * 8 + 6] = pg8::bf_lo(w.w); v[j * 8 + 7] = pg8::bf_hi(w.w); }
#pragma unroll
        for (int i = 0; i < 16; ++i) s += v[i] * v[i];
        const float r = 1.0f / sqrtf(wave_sum(s) * (1.0f / 1024.0f) + EPS);
#pragma unroll
        for (int j = 0; j < 2; ++j) { v4u o;
            o.x = pk2(v[j * 8 + 0] * r * g[j * 8 + 0], v[j * 8 + 1] * r * g[j * 8 + 1]); o.y = pk2(v[j * 8 + 2] * r * g[j * 8 + 2], v[j * 8 + 3] * r * g[j * 8 + 3]);
            o.z = pk2(v[j * 8 + 4] * r * g[j * 8 + 4], v[j * 8 + 5] * r * g[j * 8 + 5]); o.w = pk2(v[j * 8 + 6] * r * g[j * 8 + 6], v[j * 8 + 7] * r * g[j * 8 + 7]);
            zr[j * 64 + F.lane] = o; }
    }
}
__device__ __forceinline__ void phase_conv_pool(Frame& F, const float* conv_w, const float* conv_b) {
    const bf16* XBC = (const bf16*)(F.ws + WS_XBC); bf16* XBCC = (bf16*)(F.ws + WS_XBCC);
    const bf16* U = (const bf16*)(F.ws + WS_U); bf16* PO = (bf16*)(F.ws + WS_POOLED);
    const int gt = F.bid * (NWAVES * 64) + F.tid, NT = F.G * NWAVES * 64;
    for (int it = gt; it < MP * 192; it += NT) {
        const int row = it / 192, c = (it % 192) * 8, t = row & (T - 1);
        float a[8];
#pragma unroll
        for (int i = 0; i < 8; ++i) a[i] = conv_b[c + i];
#pragma unroll
        for (int k = 0; k < 4; ++k) {
            if (t - 3 + k >= 0) {
                const v4u x = *(const v4u*)(XBC + (size_t)(row - 3 + k) * 1536 + c);
                const float* w = conv_w + k * 1536 + c;
                a[0] += w[0] * pg8::bf_lo(x.x); a[1] += w[1] * pg8::bf_hi(x.x); a[2] += w[2] * pg8::bf_lo(x.y); a[3] += w[3] * pg8::bf_hi(x.y);
                a[4] += w[4] * pg8::bf_lo(x.z); a[5] += w[5] * pg8::bf_hi(x.z); a[6] += w[6] * pg8::bf_lo(x.w); a[7] += w[7] * pg8::bf_hi(x.w);
            }
        }
        v4u o; o.x = pk2(silu_f(a[0]), silu_f(a[1])); o.y = pk2(silu_f(a[2]), silu_f(a[3])); o.z = pk2(silu_f(a[4]), silu_f(a[5])); o.w = pk2(silu_f(a[6]), silu_f(a[7]));
        *(v4u*)(XBCC + (size_t)row * 1536 + c) = o;
    }
    for (int it = gt; it < MP * 64; it += NT) {
        const int row = it / 64, c = (it % 64) * 8, t = row & (T - 1), win = 2 << (c >> 7), cnt = (t + 1) < win ? (t + 1) : win;
        float s[8];
#pragma unroll
        for (int i = 0; i < 8; ++i) s[i] = 0.f;
        for (int j = 0; j < cnt; ++j) {
            const v4u x = *(const v4u*)(U + (size_t)(row - j) * 512 + c);
            s[0] += pg8::bf_lo(x.x); s[1] += pg8::bf_hi(x.x); s[2] += pg8::bf_lo(x.y); s[3] += pg8::bf_hi(x.y); s[4] += pg8::bf_lo(x.z); s[5] += pg8::bf_hi(x.z); s[6] += pg8::bf_lo(x.w); s[7] += pg8::bf_hi(x.w);
        }
        const v4u x0 = *(const v4u*)(U + (size_t)row * 512 + c); const float ic = 1.0f / (float)cnt;
        v4u o; o.x = pk2(s[0] * ic - pg8::bf_lo(x0.x), s[1] * ic - pg8::bf_hi(x0.x)); o.y = pk2(s[2] * ic - pg8::bf_lo(x0.y), s[3] * ic - pg8::bf_hi(x0.y));
        o.z = pk2(s[4] * ic - pg8::bf_lo(x0.z), s[5] * ic - pg8::bf_hi(x0.z)); o.w = pk2(s[6] * ic - pg8::bf_lo(x0.w), s[7] * ic - pg8::bf_hi(x0.w));
        *(v4u*)(PO + (size_t)row * 512 + c) = o;
    }
}
__device__ __forceinline__ unsigned f2key(float f) { const unsigned u = __float_as_uint(f); return (u & 0x80000000u) ? ~u : (u | 0x80000000u); }
__device__ __forceinline__ int mbcnt64(unsigned long long m) { return (int)__builtin_amdgcn_mbcnt_hi((unsigned)(m >> 32), __builtin_amdgcn_mbcnt_lo((unsigned)m, 0u)); }
__device__ __forceinline__ void dsa_query(Frame& F, int b_loc, int t) {
    const int lane = F.lane;
    LAS unsigned* srow = (LAS unsigned*)(F.lds + F.wave * 16384);
    LAS float* qs = (LAS float*)(F.lds + DSA_X_OFF + F.wave * 1024);
    LAS unsigned short* idxs = (LAS unsigned short*)(F.lds + DSA_X_OFF + 8 * 1024 + F.wave * 512);
    const bf16* QI = (const bf16*)(F.ws + WS_QI); const bf16* MS = (const bf16*)(F.ws + WS_MISC); const bf16* KV = (const bf16*)(F.ws + WS_KV); bf16* Q = (bf16*)(F.ws + WS_Q);
    const size_t rowq = (size_t)b_loc * T + t, rowb = (size_t)b_loc * T;
    const int n = t + 1, k = n < 256 ? n : 256, nch = (n + 63) >> 6;
    {
        const uint2 raw = *(const uint2*)(QI + rowq * 256 + lane * 4);
        qs[lane * 4 + 0] = pg8::bf_lo(raw.x); qs[lane * 4 + 1] = pg8::bf_hi(raw.x); qs[lane * 4 + 2] = pg8::bf_lo(raw.y); qs[lane * 4 + 3] = pg8::bf_hi(raw.y);
    }
    const float idx_scale = 0.0625f;
    const float w0 = bf2f(MS[rowq * 256 + 80]) * idx_scale, w1 = bf2f(MS[rowq * 256 + 81]) * idx_scale, w2 = bf2f(MS[rowq * 256 + 82]) * idx_scale, w3 = bf2f(MS[rowq * 256 + 83]) * idx_scale;
    WAVE_LDS_FENCE();
    for (int c = 0; c < nch; ++c) {
        const int s = c * 64 + lane; unsigned key = 0u;
        if (s < n) {
            const v4u* kp = (const v4u*)(MS + (rowb + s) * 256);
            float d0 = 0.f, d1 = 0.f, d2 = 0.f, d3 = 0.f;
#pragma unroll
            for (int j = 0; j < 8; ++j) {
                const v4u kv = kp[j];
                const float kf[8] = {pg8::bf_lo(kv.x), pg8::bf_hi(kv.x), pg8::bf_lo(kv.y), pg8::bf_hi(kv.y), pg8::bf_lo(kv.z), pg8::bf_hi(kv.z), pg8::bf_lo(kv.w), pg8::bf_hi(kv.w)};
                const LAS f32x4* q0 = (const LAS f32x4*)(qs + 0 * 64 + 8 * j); const LAS f32x4* q1 = (const LAS f32x4*)(qs + 1 * 64 + 8 * j);
                const LAS f32x4* q2 = (const LAS f32x4*)(qs + 2 * 64 + 8 * j); const LAS f32x4* q3 = (const LAS f32x4*)(qs + 3 * 64 + 8 * j);
                const f32x4 a0 = q0[0], a1 = q0[1], b0 = q1[0], b1 = q1[1], c0 = q2[0], c1 = q2[1], e0 = q3[0], e1 = q3[1];
                d0 += kf[0] * a0.x + kf[1] * a0.y + kf[2] * a0.z + kf[3] * a0.w + kf[4] * a1.x + kf[5] * a1.y + kf[6] * a1.z + kf[7] * a1.w;
                d1 += kf[0] * b0.x + kf[1] * b0.y + kf[2] * b0.z + kf[3] * b0.w + kf[4] * b1.x + kf[5] * b1.y + kf[6] * b1.z + kf[7] * b1.w;
                d2 += kf[0] * c0.x + kf[1] * c0.y + kf[2] * c0.z + kf[3] * c0.w + kf[4] * c1.x + kf[5] * c1.y + kf[6] * c1.z + kf[7] * c1.w;
                d3 += kf[0] * e0.x + kf[1] * e0.y + kf[2] * e0.z + kf[3] * e0.w + kf[4] * e1.x + kf[5] * e1.y + kf[6] * e1.z + kf[7] * e1.w;
            }
            const float sc = fmaxf(d0, 0.f) * w0 + fmaxf(d1, 0.f) * w1 + fmaxf(d2, 0.f) * w2 + fmaxf(d3, 0.f) * w3;
            key = f2key(sc);
        }
        srow[s] = key;
    }
    WAVE_LDS_FENCE();
    unsigned thr = 0u;
    for (int bit = 31; bit >= 0; --bit) {
        const unsigned cand = thr | (1u << bit); int cnt = 0;
        for (int c = 0; c < nch; ++c) cnt += __builtin_popcountll(__ballot(srow[c * 64 + lane] >= cand));
        if (cnt >= k) thr = cand;
    }
    int cgt = 0;
    for (int c = 0; c < nch; ++c) cgt += __builtin_popcountll(__ballot(srow[c * 64 + lane] > thr));
    const int need = k - cgt;
    {
        int base = 0, eqseen = 0;
        for (int c = 0; c < nch; ++c) {
            const unsigned key = srow[c * 64 + lane]; const bool gt = key > thr, eq = key == thr;
            const unsigned long long eqm = __ballot(eq); const int eqrank = eqseen + mbcnt64(eqm);
            const bool inc = gt || (eq && eqrank < need);
            const unsigned long long im = __ballot(inc); const int pos = base + mbcnt64(im);
            if (inc) idxs[pos] = (unsigned short)(c * 64 + lane);
            base += __builtin_popcountll(im); eqseen += __builtin_popcountll(eqm);
        }
    }
    WAVE_LDS_FENCE();
    LAS float* pT = (LAS float*)srow;
    for (int kv = 0; kv < 2; ++kv) {
        {   const uint2 raw = *(const uint2*)(Q + rowq * 512 + kv * 256 + lane * 4);
            qs[lane * 4 + 0] = pg8::bf_lo(raw.x); qs[lane * 4 + 1] = pg8::bf_hi(raw.x); qs[lane * 4 + 2] = pg8::bf_lo(raw.y); qs[lane * 4 + 3] = pg8::bf_hi(raw.y); }
        WAVE_LDS_FENCE();
        float lg[4][4];
#pragma unroll
        for (int r = 0; r < 4; ++r) {
            const int i = lane + 64 * r;
            float d0 = 0.f, d1 = 0.f, d2 = 0.f, d3 = 0.f;
            if (i < k) {
                const int s = idxs[i];
                const v4u* kp = (const v4u*)(KV + (rowb + s) * 256 + kv * 64);
#pragma unroll
                for (int j = 0; j < 8; ++j) {
                    const v4u kx = kp[j];
                    const float kf[8] = {pg8::bf_lo(kx.x), pg8::bf_hi(kx.x), pg8::bf_lo(kx.y), pg8::bf_hi(kx.y), pg8::bf_lo(kx.z), pg8::bf_hi(kx.z), pg8::bf_lo(kx.w), pg8::bf_hi(kx.w)};
                    const LAS f32x4* q0 = (const LAS f32x4*)(qs + 0 * 64 + 8 * j); const LAS f32x4* q1 = (const LAS f32x4*)(qs + 1 * 64 + 8 * j);
                    const LAS f32x4* q2 = (const LAS f32x4*)(qs + 2 * 64 + 8 * j); const LAS f32x4* q3 = (const LAS f32x4*)(qs + 3 * 64 + 8 * j);
                    const f32x4 a0 = q0[0], a1 = q0[1], b0 = q1[0], b1 = q1[1], c0 = q2[0], c1 = q2[1], e0 = q3[0], e1 = q3[1];
                    d0 += kf[0] * a0.x + kf[1] * a0.y + kf[2] * a0.z + kf[3] * a0.w + kf[4] * a1.x + kf[5] * a1.y + kf[6] * a1.z + kf[7] * a1.w;
                    d1 += kf[0] * b0.x + kf[1] * b0.y + kf[2] * b0.z + kf[3] * b0.w + kf[4] * b1.x + kf[5] * b1.y + kf[6] * b1.z + kf[7] * b1.w;
                    d2 += kf[0] * c0.x + kf[1] * c0.y + kf[2] * c0.z + kf[3] * c0.w + kf[4] * c1.x + kf[5] * c1.y + kf[6] * c1.z + kf[7] * c1.w;
                    d3 += kf[0] * e0.x + kf[1] * e0.y + kf[2] * e0.z + kf[3] * e0.w + kf[4] * e1.x + kf[5] * e1.y + kf[6] * e1.z + kf[7] * e1.w;
                }
                lg[r][0] = d0 * 0.125f; lg[r][1] = d1 * 0.125f; lg[r][2] = d2 * 0.125f; lg[r][3] = d3 * 0.125f;
            } else { lg[r][0] = -INFINITY; lg[r][1] = -INFINITY; lg[r][2] = -INFINITY; lg[r][3] = -INFINITY; }
        }
        float inv[4];
#pragma unroll
        for (int h = 0; h < 4; ++h) {
            const float mx = wave_max(fmaxf(fmaxf(lg[0][h], lg[1][h]), fmaxf(lg[2][h], lg[3][h])));
            float e = 0.f;
#pragma unroll
            for (int r = 0; r < 4; ++r) { lg[r][h] = __expf(lg[r][h] - mx); e += lg[r][h]; }
            inv[h] = 1.0f / wave_sum(e);
        }
#pragma unroll
        for (int r = 0; r < 4; ++r) { const int i = lane + 64 * r; *(LAS f32x4*)(pT + i * 4) = (f32x4){lg[r][0] * inv[0], lg[r][1] * inv[1], lg[r][2] * inv[2], lg[r][3] * inv[3]}; }
        WAVE_LDS_FENCE();
        float o0 = 0.f, o1 = 0.f, o2 = 0.f, o3 = 0.f;
        const bf16* vb = KV + rowb * 256 + 128 + kv * 64 + lane;
#pragma unroll 8
        for (int i = 0; i < k; ++i) {
            const int s = idxs[i]; const f32x4 p = *(const LAS f32x4*)(pT + i * 4);
            const float v = bf2f(vb[(size_t)s * 256]);
            o0 += p.x * v; o1 += p.y * v; o2 += p.z * v; o3 += p.w * v;
        }
        bf16* op = Q + rowq * 512 + kv * 256 + lane;
        op[0] = (bf16)f2bf(o0); op[64] = (bf16)f2bf(o1); op[128] = (bf16)f2bf(o2); op[192] = (bf16)f2bf(o3);
        WAVE_LDS_FENCE();
    }
}
__device__ __forceinline__ void phase_dsa(Frame& F) {
    for (int i = 0;; ++i) {
        const long u = (long)F.bid + (long)F.G * i; if (u >= NBP * 512) break;
        const int b_loc = (int)(u / 512), r = (int)(u % 512), qb = r < 256 ? r : 511 - (r - 256);
        dsa_query(F, b_loc, qb * 8 + F.wave);
    }
}
__device__ __forceinline__ void phase_ssd_recur(Frame& F, const float* dt_bias, const float* a_log, const float* d_skip) {
    const bf16* XC = (const bf16*)(F.ws + WS_XBCC); const bf16* MS = (const bf16*)(F.ws + WS_MISC); bf16* Z = (bf16*)(F.ws + WS_Z);
    LAS float* sB = (LAS float*)(F.lds); LAS float* sC = (LAS float*)(F.lds + 32768); LAS float* sX = (LAS float*)(F.lds + 65536); LAS float* sY = (LAS float*)(F.lds + 69632);
    LAS float* sdt = (LAS float*)(F.lds + 73728); LAS float* sdA = (LAS float*)(F.lds + 73984);
    const int tid = F.tid, lane = F.lane, w = F.wave;
    for (int u = F.bid; u < NBP * 64; u += F.G) {
        const int b_loc = u >> 6, h = (u >> 2) & 15, p0 = (u & 3) * 16, g = h >> 3;
        const float A = -__expf(a_log[h]), bias = dt_bias[h], Dh = d_skip[h];
        float s00 = 0.f, s01 = 0.f, s10 = 0.f, s11 = 0.f;
        for (int ch = 0; ch < T / 64; ++ch) {
            const size_t row0 = (size_t)b_loc * T + ch * 64;
#pragma unroll 4
            for (int e = tid; e < 64 * 128; e += NWAVES * 64) { const int tt = e >> 7, nn = e & 127; const bf16* rp = XC + (row0 + tt) * 1536;
                sB[e] = bf2f(rp[1024 + g * 128 + nn]); sC[e] = bf2f(rp[1280 + g * 128 + nn]); }
#pragma unroll
            for (int e = tid; e < 64 * 16; e += NWAVES * 64) { const int tt = e >> 4, pp = e & 15; sX[e] = bf2f(XC[(row0 + tt) * 1536 + h * 64 + p0 + pp]); }
            if (tid < 64) { const float raw = bf2f(MS[(row0 + tid) * 256 + 64 + h]) + bias; const float dt = raw > 20.f ? raw : log1pf(__expf(raw)); sdt[tid] = dt; sdA[tid] = __expf(dt * A); }
            __syncthreads();
            for (int tt = 0; tt < 64; ++tt) {
                const float dA = sdA[tt], dt = sdt[tt], x0 = sX[tt * 16 + 2 * w] * dt, x1 = sX[tt * 16 + 2 * w + 1] * dt;
                const float b0 = sB[tt * 128 + lane], b1 = sB[tt * 128 + 64 + lane], c0 = sC[tt * 128 + lane], c1 = sC[tt * 128 + 64 + lane];
                s00 = s00 * dA + x0 * b0; s01 = s01 * dA + x0 * b1; s10 = s10 * dA + x1 * b0; s11 = s11 * dA + x1 * b1;
                const float y0 = wave_sum(s00 * c0 + s01 * c1), y1 = wave_sum(s10 * c0 + s11 * c1);
                if (lane == 0) { sY[tt * 16 + 2 * w] = y0; sY[tt * 16 + 2 * w + 1] = y1; }
            }
            __syncthreads();
#pragma unroll
            for (int e = tid; e < 64 * 16; e += NWAVES * 64) { const int tt = e >> 4, pp = e & 15; const size_t zi = (row0 + tt) * 1024 + h * 64 + p0 + pp;
                const float y = sY[e] + Dh * sX[e]; Z[zi] = (bf16)f2bf(y * silu_f(bf2f(Z[zi]))); }
            __syncthreads();
        }
    }
}
struct Args { const float* in[19]; float* out; unsigned char* ws; int lo, hi; };
static_assert(sizeof(Args) == 21 * 8 + 8, "Args has no holes");
#define CAS __attribute__((address_space(4)))
__device__ __forceinline__ const CAS Args* kargs() { const CAS Args* p = (const CAS Args*)__builtin_amdgcn_kernarg_segment_ptr(); asm volatile("" : "+s"(p)); return p; }
__device__ __forceinline__ Frame mkframe(const CAS Args* A, LAS unsigned char* lds) {
    Frame F; F.lds = lds; F.MISC = (volatile LAS unsigned*)(lds + MISC_OFF);
    int t_ = threadIdx.x; asm volatile("" : "+v"(t_));
    F.tid = t_; F.lane = t_ & 63; F.wave = __builtin_amdgcn_readfirstlane(t_ >> 6);
    F.G = gridDim.x; F.bid = blockIdx.x; F.ws = A->ws; F.ctl = (gu32*)(F.ws + WS_CTL);
    return F;
}
__global__ void __launch_bounds__(NWAVES * 64, 2) trunk_fwd(Args args) {
    extern __shared__ __attribute__((aligned(16))) unsigned char lds[];
    LAS unsigned char* const L = (LAS unsigned char*)lds;
    for (int u = threadIdx.x; u < (DSA_X_OFF - LDSCTL_OFF) / 4; u += NWAVES * 64) ((LAS unsigned*)(L + LDSCTL_OFF))[u] = 0u;
    __syncthreads();
    { const CAS Args* A = kargs(); (void)xcd_barrier_post((unsigned*)(A->ws + WS_CTL) + 4096, (volatile LAS unsigned*)(L + MISC_OFF) + 8); }
    const int lo = args.lo, hi = args.hi;
#ifndef PHASE_MASK
#define PHASE_MASK 0x7ff
#endif
#define PH(k) (((PHASE_MASK) >> (k)) & 1)
#define RUN(s) (lo <= (s) && (s) < hi)
#define SEAM(s) do { if (RUN(s) && RUN((s) + 1)) { const CAS Args* A_ = kargs(); XcdBarrier bar_; bar_.bar = (unsigned*)(A_->ws + WS_CTL) + 4096; bar_.x = xb_xcc_id(); bar_.st = (volatile LAS unsigned*)(L + MISC_OFF) + 8; xcd_barrier(bar_); } } while (0)
    for (int l = 0; l < NL; ++l) {
        const int sb = l * 16;
        if (PH(0) && RUN(sb)) {
            const CAS Args* A = kargs(); Frame F = mkframe(A, L);
            LayerW W; W.w_in = A->in[2] + (size_t)l * D * INW; W.w_us = A->in[11] + (size_t)l * D * D; W.w_ua = A->in[12] + (size_t)l * 512 * D; W.w_up = A->in[13] + (size_t)l * 512 * D;
            W.w_out = A->in[14] + (size_t)l * D * D; W.w_fi = A->in[16] + (size_t)l * D * 2 * FFH; W.w_fo = A->in[17] + (size_t)l * FFH * D; W.pool_w = A->in[9] + (size_t)l * 4 * 128 * 128; W.pool_scale = A->in[10] + (size_t)l * 512;
            phase_convert(F, W);
            phase_norm_bf16(F, l == 0 ? A->in[0] : A->out, A->in[1] + (size_t)l * D, (bf16*)(F.ws + WS_XN), M);
        }
        SEAM(sb);
        for (int p = 0; p < NPASS; ++p) {
            const int s1 = sb + 1 + p * 6;
            if (PH(1) && RUN(s1)) {
                const CAS Args* A = kargs(); Frame F = mkframe(A, L); unsigned char* ws = F.ws;
                pg8::Gemm g{(const bf16*)(ws + WS_XN) + (size_t)p * MP * D, (const bf16*)(ws + WS_WIN), MP, INW_PAD, D}; pg8::StaticOrder S; S.init(MP, INW_PAD, F.G, F.bid);
                pg8::EpiProj E{ws};
                pg8::gemm_phase<pg8::EpiProj, pg8::StaticOrder, true, true>(F.lds, g, S, E);
            }
            SEAM(s1);
            if (PH(2) && RUN(s1 + 1)) {
                const CAS Args* A = kargs(); Frame F = mkframe(A, L);
                phase_conv_pool(F, A->in[3] + (size_t)l * 4 * 1536, A->in[4] + (size_t)l * 1536);
                phase_dsa(F);
            }
            SEAM(s1 + 1);
            if (PH(3) && RUN(s1 + 2)) { const CAS Args* A = kargs(); Frame F = mkframe(A, L); phase_ssd_recur(F, A->in[5] + l * 16, A->in[6] + l * 16, A->in[7] + l * 16); }
            SEAM(s1 + 2);
            if (PH(4) && RUN(s1 + 3)) { const CAS Args* A = kargs(); Frame F = mkframe(A, L); phase_ssdnorm(F, (bf16*)(F.ws + WS_Z), A->in[8] + (size_t)l * D); }
            SEAM(s1 + 3);
#ifndef MSUB
#define MSUB 7
#endif
            if (PH(5) && (MSUB & 1) && RUN(s1 + 4)) {
                const CAS Args* A = kargs(); Frame F = mkframe(A, L); unsigned char* ws = F.ws;
                pg8::Gemm g{(const bf16*)(ws + WS_Z), (const bf16*)(ws + WS_WUS), MP, D, D}; pg8::StaticOrder S; S.init(MP, D, F.G, F.bid);
                pg8::EpiMerge<true> E{(const bf16*)(ws + WS_GATES), (bf16*)(ws + WS_MERGED)}; pg8::gemm_phase<pg8::EpiMerge<true>, pg8::StaticOrder, true, true>(F.lds, g, S, E);
            }
            if (PH(5) && (MSUB & 2) && RUN(s1 + 4)) {
                const CAS Args* A = kargs(); Frame F = mkframe(A, L); unsigned char* ws = F.ws;
                pg8::Gemm g{(const bf16*)(ws + WS_Q), (const bf16*)(ws + WS_WUA), MP, D, 512}; pg8::StaticOrder S; S.init(MP, D, F.G, F.bid);
                pg8::EpiMerge<false> E{(const bf16*)(ws + WS_GATES) + 1024, (bf16*)(ws + WS_MERGED)}; pg8::gemm_phase<pg8::EpiMerge<false>, pg8::StaticOrder, true, true>(F.lds, g, S, E);
            }
            if (PH(5) && (MSUB & 4) && RUN(s1 + 4)) {
                const CAS Args* A = kargs(); Frame F = mkframe(A, L); unsigned char* ws = F.ws;
                pg8::Gemm g{(const bf16*)(ws + WS_POOLED), (const bf16*)(ws + WS_WUP), MP, D, 512}; pg8::StaticOrder S; S.init(MP, D, F.G, F.bid);
                pg8::EpiMerge<false> E{(const bf16*)(ws + WS_GATES) + 2048, (bf16*)(ws + WS_MERGED)}; pg8::gemm_phase<pg8::EpiMerge<false>, pg8::StaticOrder, true, true>(F.lds, g, S, E);
            }
            SEAM(s1 + 4);
            if (PH(6) && RUN(s1 + 5)) {
                const CAS Args* A = kargs(); Frame F = mkframe(A, L); unsigned char* ws = F.ws;
                pg8::Gemm g{(const bf16*)(ws + WS_MERGED), (const bf16*)(ws + WS_WOUT), MP, D, D}; pg8::StaticOrder S; S.init(MP, D, F.G, F.bid);
                pg8::EpiResid E{(l == 0 ? A->in[0] : A->out) + (size_t)p * MP * D, A->out + (size_t)p * MP * D, D};
                pg8::gemm_phase<pg8::EpiResid, pg8::StaticOrder, true, true>(F.lds, g, S, E);
            }
            SEAM(s1 + 5);
        }
        if (PH(7) && RUN(sb + 13)) { const CAS Args* A = kargs(); Frame F = mkframe(A, L); phase_norm_bf16(F, A->out, A->in[15] + (size_t)l * D, (bf16*)(F.ws + WS_XN), M); }
        SEAM(sb + 13);
        if (PH(8) && RUN(sb + 14)) {
            const CAS Args* A = kargs(); Frame F = mkframe(A, L); unsigned char* ws = F.ws;
            pg8::Gemm g{(const bf16*)(ws + WS_XN), (const bf16*)(ws + WS_WFI), M, 2 * FFH, D}; pg8::StaticOrder S; S.init(M, 2 * FFH, F.G, F.bid);
            pg8::EpiSwiGLU E{(bf16*)(ws + WS_ACT), FFH};
            pg8::gemm_phase<pg8::EpiSwiGLU, pg8::StaticOrder, true, true>(F.lds, g, S, E);
        }
        SEAM(sb + 14);
        if (PH(9) && RUN(sb + 15)) {
            const CAS Args* A = kargs(); Frame F = mkframe(A, L); unsigned char* ws = F.ws;
            pg8::Gemm g{(const bf16*)(ws + WS_ACT), (const bf16*)(ws + WS_WFO), M, D, FFH}; pg8::StaticOrder S; S.init(M, D, F.G, F.bid);
            pg8::EpiResid E{A->out, A->out, D};
            pg8::gemm_phase<pg8::EpiResid, pg8::StaticOrder, true, true>(F.lds, g, S, E);
        }
        SEAM(sb + 15);
    }
    if (PH(10) && RUN(NL * 16)) { const CAS Args* A = kargs(); Frame F = mkframe(A, L); phase_norm_f32_inplace(F, A->out, A->in[18], M); }
#undef RUN
#undef SEAM
}

#ifndef N_LAUNCH_SPLIT
#define N_LAUNCH_SPLIT 1
#endif
extern "C" void kernel_launch(void* const* d_in, const int* in_sizes, int n_in, void* d_out, int out_size, void* d_ws, size_t ws_size, hipStream_t stream) {
    static int grid = 0;
    if (grid == 0) {
        if (n_in != 19 || in_sizes[0] != M * D || out_size != M * D || ws_size < WS_END) { fprintf(stderr, "kernel_launch: unexpected shapes / workspace (n_in %d, in0 %d, out %d, ws %zu); nothing launched\n", n_in, n_in > 0 ? in_sizes[0] : -1, out_size, ws_size); grid = -1; return; }
        int dev = 0, cus = 0, per_cu = 0;
        if (hipGetDevice(&dev) != hipSuccess || hipDeviceGetAttribute(&cus, hipDeviceAttributeMultiprocessorCount, dev) != hipSuccess) { grid = -1; return; }
        if (hipFuncSetAttribute((const void*)trunk_fwd, hipFuncAttributeMaxDynamicSharedMemorySize, LDS_BYTES) != hipSuccess) { fprintf(stderr, "kernel_launch: hipFuncSetAttribute failed\n"); grid = -1; return; }
        if (hipOccupancyMaxActiveBlocksPerMultiprocessor(&per_cu, (const void*)trunk_fwd, NWAVES * 64, LDS_BYTES) != hipSuccess || per_cu < 1) { fprintf(stderr, "kernel_launch: occupancy query reports %d workgroups per CU\n", per_cu); }
        (void)hipGetLastError();
        grid = cus;
    }
    if (grid < 0) return;
    if (hipMemsetAsync((char*)d_ws + WS_CTL, 0, CTL_ZERO_BYTES, stream) != hipSuccess) return;
    Args a{};
    for (int i = 0; i < 19; ++i) a.in[i] = (const float*)d_in[i];
    a.out = (float*)d_out; a.ws = (unsigned char*)d_ws;
#if N_LAUNCH_SPLIT
    for (int s = 0; s < NSTEPS; ++s) { a.lo = s; a.hi = s + 1; hipLaunchKernelGGL(trunk_fwd, dim3(grid), dim3(NWAVES * 64), LDS_BYTES, stream, a); }
#else
    a.lo = 0; a.hi = NSTEPS; hipLaunchKernelGGL(trunk_fwd, dim3(grid), dim3(NWAVES * 64), LDS_BYTES, stream, a);
#endif
}
```

```cpp
#include <hip/hip_runtime.h>
#include <cstdio>
#include <cstdint>

constexpr int NB = 8, T = 4096, D = 1024, NL = 4, M = NB * T;
constexpr int NBP = 4, MP = NBP * T, NPASS = NB / NBP;
constexpr int INW = 7252, INW_PAD = 7424, FFH = 2816;
constexpr float EPS = 1e-6f;
constexpr size_t MiB = 1u << 20;
constexpr size_t WS_CTL = 0, CTL_ZERO_BYTES = 1 * MiB;
constexpr size_t WS_WIN = 2 * MiB, WS_WUS = 17 * MiB, WS_WUA = 19 * MiB, WS_WUP = 20 * MiB, WS_WOUT = 21 * MiB, WS_WFI = 23 * MiB, WS_WFO = 34 * MiB;
constexpr size_t WS_XN = 40 * MiB;
constexpr size_t WS_Z = 104 * MiB, WS_XBC = 136 * MiB, WS_Q = 184 * MiB, WS_KV = 200 * MiB, WS_QI = 208 * MiB, WS_U = 216 * MiB,
                 WS_GATES = 240 * MiB, WS_XBCC = 336 * MiB, WS_YAP = 384 * MiB, WS_MISC = 416 * MiB, WS_STATES = 432 * MiB, WS_DEC = 464 * MiB, WS_SSQ = 465 * MiB, WS_PSS = 466 * MiB, WS_KI = 468 * MiB, WS_MERGED = 472 * MiB, WS_END = 504 * MiB;
constexpr size_t WS_ACT = 104 * MiB;
static_assert(WS_ACT + (size_t)M * FFH * 2 <= WS_STATES, "ACT overlay");
namespace pg8 {
#define PG8_LAS __attribute__((address_space(3)))
typedef unsigned short bf16_t;
typedef short bf16x8 __attribute__((ext_vector_type(8)));
typedef float f32x4 __attribute__((ext_vector_type(4)));
typedef unsigned u32x4 __attribute__((ext_vector_type(4)));
constexpr int BM = 256, BK = 64, HALF = 128, HTB = HALF * BK * 2  , STAGE_BYTES = 8 * HTB, NXCD = 8, WGM = 8;

__host__ __device__ __forceinline__ int lds_byte(int r, int c) { const int st = (r >> 4) * 2 + (c >> 5), rr = r & 15, cc = c & 31, ob = rr * 64 + cc * 2; return st * 1024 + (ob ^ (((ob >> 9) & 1) << 5)); }
__host__ __device__ __forceinline__ void stage_rc(int b, int& R, int& C) { const int st = b / 1024, sb = b % 1024, swz = sb ^ (((sb >> 9) & 1) << 5); R = (st >> 1) * 16 + swz / 64; C = (st & 1) * 32 + (swz % 64) / 2; }
__host__ __device__ __forceinline__ int perm32(int rho) { const int n = rho >> 4, i = rho & 15; return 8 * (i >> 2) + 4 * n + (i & 3); }

struct Unit { int pm, pn, br; };
struct Gemm { const bf16_t* A; const bf16_t* Bt; int M, N, K; };

struct StaticOrder {
    int nM, nN, nwg, G, c;
    __host__ __device__ void init(int M, int N, int G_, int c_) { nM = M / BM; nN = N / BM; nwg = nM * nN; G = G_; c = c_; }
    __host__ __device__ bool next(int i, Unit& u) const {
        const long L = (long)i * G + c; if (L >= nwg) return false;
        int wgid = (int)L; { const int q = nwg / NXCD, r = nwg % NXCD, xcd = wgid % NXCD, off = wgid / NXCD; wgid = (xcd < r ? xcd * (q + 1) : r * (q + 1) + (xcd - r) * q) + off; }
        const int nig = WGM * nN, gid = wgid / nig, fm = gid * WGM, gsz = (nM - fm) < WGM ? (nM - fm) : WGM;
        u.pm = fm + ((wgid % nig) % gsz); u.pn = (wgid % nig) / gsz; return true;
    }
    __device__ __forceinline__ void a_ready(const Unit&) const {}
    __device__ __forceinline__ void done(const Unit&) const {}
};

__device__ __forceinline__ unsigned cvt_pk_bf16(float lo, float hi) { unsigned r; asm volatile("v_cvt_pk_bf16_f32 %0, %1, %2" : "=v"(r) : "v"(lo), "v"(hi)); return r; }
typedef float f32x2 __attribute__((ext_vector_type(2)));
__device__ __forceinline__ float bf_lo(unsigned w) { return __uint_as_float(w << 16); }
__device__ __forceinline__ float bf_hi(unsigned w) { return __uint_as_float(w & 0xffff0000u); }
__device__ __forceinline__ float sigm(float x) { return __builtin_amdgcn_rcpf(1.0f + __expf(-x)); }
__device__ __forceinline__ float row_rstd(const float* p4) { const f32x4 a = *(const f32x4*)p4; return __builtin_amdgcn_rsqf(((a[0] + a[1]) + (a[2] + a[3])) * (1.0f / 1024.0f) + 1e-6f); }
__device__ __forceinline__ float row_rstd2(const float* p2) { typedef float f32x2v __attribute__((ext_vector_type(2))); const f32x2v a = *(const f32x2v*)p2; return __builtin_amdgcn_rsqf((a[0] + a[1]) * (1.0f / 1024.0f) + 1e-6f); }

struct RstdTab { const PG8_LAS float* tab; int pmA, pmB; const float* pss;
    __device__ __forceinline__ float get(int pm, int rl) const { return pm == pmA ? tab[rl] : (pm == pmB ? tab[BM + rl] : row_rstd(pss + (size_t)(pm * BM + rl) * 4)); } };
struct EpiProj {
    static constexpr bool PERM = true, AFTER_DRAIN = false;
    unsigned char* ws; RstdTab rt;
    __device__ __forceinline__ void operator()(const f32x4 (&acc)[2][2][4][2], const Unit& u, int wr, int wc, int fr, int fq) const {
        const int pn = u.pn; size_t off; int ldc, c0;
        if (pn < 4)       { off = WS_Z;     ldc = 1024; c0 = pn * 256; }
        else if (pn < 10) { off = WS_XBC;   ldc = 1536; c0 = (pn - 4) * 256; }
        else if (pn < 12) { off = WS_Q;     ldc = 512;  c0 = (pn - 10) * 256; }
        else if (pn < 13) { off = WS_KV;    ldc = 256;  c0 = 0; }
        else if (pn < 14) { off = WS_QI;    ldc = 256;  c0 = 0; }
        else if (pn < 16) { off = WS_U;     ldc = 512;  c0 = (pn - 14) * 256; }
        else if (pn < 28) { off = WS_GATES; ldc = 3072; c0 = (pn - 16) * 256; }
        else              { off = WS_MISC;  ldc = 256;  c0 = 0; }
        bf16_t* base = (bf16_t*)(ws + off);
        const int row0 = u.pm * BM + wr * 64 + fr, col0 = c0 + wc * 32 + 8 * fq;
        float rsv[2][4];
#pragma unroll
        for (int ai = 0; ai < 2; ++ai)
#pragma unroll
            for (int m = 0; m < 4; ++m) rsv[ai][m] = rt.get(u.pm, wr * 64 + fr + ai * HALF + m * 16);
#pragma unroll
        for (int ai = 0; ai < 2; ++ai)
#pragma unroll
            for (int m = 0; m < 4; ++m) { const int row = row0 + ai * HALF + m * 16; bf16_t* rowp = base + (size_t)row * ldc + col0; const float rs = rsv[ai][m];
#pragma unroll
                for (int bj = 0; bj < 2; ++bj) { const f32x4 v0 = acc[ai][bj][m][0] * rs, v1 = acc[ai][bj][m][1] * rs;
                    u32x4 w; w.x = cvt_pk_bf16(v0[0], v0[1]); w.y = cvt_pk_bf16(v0[2], v0[3]); w.z = cvt_pk_bf16(v1[0], v1[1]); w.w = cvt_pk_bf16(v1[2], v1[3]);
                    if (pn == 28 && bj == 0 && wc < 2) *(u32x4*)((bf16_t*)(ws + WS_KI) + (size_t)row * 64 + col0) = w;
                    __builtin_nontemporal_store(w, (u32x4*)(rowp + bj * HALF));
#if defined(DUP_MASK) && ((DUP_MASK >> 13) & 1)
                    { const size_t o2 = ((size_t)((const char*)(rowp + bj * HALF) - (const char*)ws)) & (32 * MiB - 1); *(u32x4*)(ws + WS_STATES + o2) = w; }
#endif
                    } }
    }
};
struct EpiSwiGLU {
    static constexpr bool PERM = true, AFTER_DRAIN = false;
    bf16_t* O; int ldc; RstdTab rt;
    __device__ __forceinline__ void operator()(const f32x4 (&acc)[2][2][4][2], const Unit& u, int wr, int wc, int fr, int fq) const {
        const int row0 = u.pm * BM + wr * 64 + fr, col0 = u.pn * HALF + wc * 32 + 8 * fq;
        float rsv[2][4];
#pragma unroll
        for (int ai = 0; ai < 2; ++ai)
#pragma unroll
            for (int m = 0; m < 4; ++m) rsv[ai][m] = rt.get(u.pm, wr * 64 + fr + ai * HALF + m * 16);
#pragma unroll
        for (int ai = 0; ai < 2; ++ai)
#pragma unroll
            for (int m = 0; m < 4; ++m) { const int row = row0 + ai * HALF + m * 16; bf16_t* rowp = O + (size_t)row * ldc + col0; const float rs = rsv[ai][m];
                float r[8];
#pragma unroll
                for (int n = 0; n < 2; ++n)
#pragma unroll
                    for (int i = 0; i < 4; ++i) { const float a = acc[ai][0][m][n][i] * rs, b = acc[ai][1][m][n][i] * rs; r[n * 4 + i] = a * sigm(a) * b; }
                u32x4 w; w.x = cvt_pk_bf16(r[0], r[1]); w.y = cvt_pk_bf16(r[2], r[3]); w.z = cvt_pk_bf16(r[4], r[5]); w.w = cvt_pk_bf16(r[6], r[7]);
                *(u32x4*)rowp = w; }
    }
};
struct EpiResid {
    static constexpr bool PERM = true, AFTER_DRAIN = false;
    bf16_t* xn; float* pss; PG8_LAS float* part;
    __device__ __forceinline__ void operator()(const f32x4 (&acc)[2][2][4][2], const Unit& u, int wr, int wc, int fr, int fq) const {
        const int row0 = u.pm * BM + wr * 64 + fr, col0 = u.pn * BM + wc * 32 + 8 * fq;
#pragma unroll
        for (int ai = 0; ai < 2; ++ai) {
            u32x4 hw[4][2];
#pragma unroll
            for (int m = 0; m < 4; ++m)
#pragma unroll
                for (int bj = 0; bj < 2; ++bj) hw[m][bj] = *(const u32x4*)(xn + (size_t)(row0 + ai * HALF + m * 16) * 1024 + col0 + bj * HALF);
#pragma unroll
            for (int m = 0; m < 4; ++m) { bf16_t* rowp = xn + (size_t)(row0 + ai * HALF + m * 16) * 1024 + col0; float ss = 0.f;
#pragma unroll
                for (int bj = 0; bj < 2; ++bj) { const u32x4 h4 = hw[m][bj]; const f32x4 v0 = acc[ai][bj][m][0], v1 = acc[ai][bj][m][1];
                    float r[8];
                    r[0] = bf_lo(h4.x) + v0[0]; r[1] = bf_hi(h4.x) + v0[1]; r[2] = bf_lo(h4.y) + v0[2]; r[3] = bf_hi(h4.y) + v0[3];
                    r[4] = bf_lo(h4.z) + v1[0]; r[5] = bf_hi(h4.z) + v1[1]; r[6] = bf_lo(h4.w) + v1[2]; r[7] = bf_hi(h4.w) + v1[3];
                    ss += ((r[0] * r[0] + r[1] * r[1]) + (r[2] * r[2] + r[3] * r[3])) + ((r[4] * r[4] + r[5] * r[5]) + (r[6] * r[6] + r[7] * r[7]));
                    u32x4 w; w.x = cvt_pk_bf16(r[0], r[1]); w.y = cvt_pk_bf16(r[2], r[3]); w.z = cvt_pk_bf16(r[4], r[5]); w.w = cvt_pk_bf16(r[6], r[7]);
                    *(u32x4*)(rowp + bj * HALF) = w; }
                ss += __shfl_xor(ss, 16); ss += __shfl_xor(ss, 32);
                if (fq == 0) part[(ai * HALF + wr * 64 + m * 16 + fr) * 4 + wc] = ss; }
        }
        asm volatile("s_waitcnt lgkmcnt(0)" ::: "memory"); __builtin_amdgcn_s_barrier(); asm volatile("" ::: "memory");
        int t = threadIdx.x; asm volatile("" : "+v"(t));
        if (t < BM) { const f32x4 q = *(const PG8_LAS f32x4*)(part + t * 4); pss[(size_t)(u.pm * BM + t) * 4 + u.pn] = (q[0] + q[1]) + (q[2] + q[3]); }
    }
};
__device__ __forceinline__ float gclamp(float g) { return fminf(fmaxf(g, -30.f), 30.f); }
__device__ __forceinline__ float gratio(float gn, float gd) { return (1.0f + __expf(-gclamp(gd))) * __builtin_amdgcn_rcpf(1.0f + __expf(-gclamp(gn))); }
struct EpiMergeChain {
    static constexpr bool PERM = true, AFTER_DRAIN = false;
    const bf16_t* gates; bf16_t* P; const float* ssq;
    __device__ __forceinline__ void operator()(f32x4 (&acc)[2][2][4][2], const Unit& u, int wr, int wc, int fr, int fq) const {
        const int row0 = u.pm * BM + wr * 64 + fr, col0 = u.pn * BM + wc * 32 + 8 * fq;
        if (u.br < 2) {
            const bf16_t* gn = gates + u.br * 1024; const bool first = u.br == 0;
#pragma unroll
            for (int ai = 0; ai < 2; ++ai)
#pragma unroll
                for (int m = 0; m < 4; ++m) { const size_t row = (size_t)(row0 + ai * HALF + m * 16); const float rs = first ? row_rstd2(ssq + row * 2) : 1.0f;
#pragma unroll
                    for (int bj = 0; bj < 2; ++bj) { const u32x4 x = *(const u32x4*)(gn + row * 3072 + col0 + bj * HALF), y = *(const u32x4*)(gn + 1024 + row * 3072 + col0 + bj * HALF);
                        { const f32x4 r0 = (f32x4){gratio(bf_lo(x.x), bf_lo(y.x)), gratio(bf_hi(x.x), bf_hi(y.x)), gratio(bf_lo(x.y), bf_lo(y.y)), gratio(bf_hi(x.y), bf_hi(y.y))};
                          acc[ai][bj][m][0] = acc[ai][bj][m][0] * (r0 * rs); asm volatile("" : "+v"(acc[ai][bj][m][0])); }
                        { const f32x4 r1 = (f32x4){gratio(bf_lo(x.z), bf_lo(y.z)), gratio(bf_hi(x.z), bf_hi(y.z)), gratio(bf_lo(x.w), bf_lo(y.w)), gratio(bf_hi(x.w), bf_hi(y.w))};
                          acc[ai][bj][m][1] = acc[ai][bj][m][1] * (r1 * rs); asm volatile("" : "+v"(acc[ai][bj][m][1])); } }
                    asm volatile("" ::: "memory"); }
        } else {
            const bf16_t* g3 = gates + 2048;
#pragma unroll
            for (int ai = 0; ai < 2; ++ai)
#pragma unroll
                for (int m = 0; m < 4; ++m) { const size_t row = (size_t)(row0 + ai * HALF + m * 16);
#pragma unroll
                    for (int bj = 0; bj < 2; ++bj) { const u32x4 x = *(const u32x4*)(g3 + row * 3072 + col0 + bj * HALF); const f32x4 v0 = acc[ai][bj][m][0], v1 = acc[ai][bj][m][1];
                        u32x4 w; w.x = cvt_pk_bf16(v0[0] * sigm(gclamp(bf_lo(x.x))), v0[1] * sigm(gclamp(bf_hi(x.x)))); w.y = cvt_pk_bf16(v0[2] * sigm(gclamp(bf_lo(x.y))), v0[3] * sigm(gclamp(bf_hi(x.y))));
                        w.z = cvt_pk_bf16(v1[0] * sigm(gclamp(bf_lo(x.z))), v1[1] * sigm(gclamp(bf_hi(x.z)))); w.w = cvt_pk_bf16(v1[2] * sigm(gclamp(bf_lo(x.w))), v1[3] * sigm(gclamp(bf_hi(x.w))));
                        *(u32x4*)(P + row * 1024 + col0 + bj * HALF) = w; }
                    if (m & 1) asm volatile("" ::: "memory"); }
        }
    }
};

template <class Epi, class Sched, bool ALIGN_EPI = false, bool SP2 = false, bool HET = false>
__device__ __forceinline__ void gemm_phase(PG8_LAS unsigned char* lds, const Gemm g, const Sched& S, const Epi& E) {
    int tid_ = threadIdx.x; asm volatile("" : "+v"(tid_));
    const int tid = tid_, wid = __builtin_amdgcn_readfirstlane(tid >> 6), lane = tid & 63, wr = wid >> 2, wc = wid & 3, fr = lane & 15, fq = lane >> 4;
    const int K = g.K; int nt = K / BK;
    unsigned voffA[2], voffB[2];
#pragma unroll
    for (int i = 0; i < 2; ++i) { int R, C; stage_rc(tid * 16 + i * 8192, R, C); const int Rb = Epi::PERM ? ((R & ~31) + perm32(R & 31)) : R;
        voffA[i] = (unsigned)(R * K + C) * 2u; voffB[i] = (unsigned)(Rb * K + C) * 2u; }
    const size_t kstep = (size_t)(BK * 2);
    const size_t hstep = (size_t)HALF * K * 2;
    const size_t tstep = 2 * hstep;
    const unsigned ldsw = (unsigned)wid * 1024u;
    const int aoff = lds_byte(wr * 64 + fr, fq * 8), boff = lds_byte(wc * 32 + fr, fq * 8);
#define PG8_SA(b, h) (((b) * 2 + (h)) * HTB)
#define PG8_SB(b, h) ((4 + (b) * 2 + (h)) * HTB)
#define PG8_STAGE(bufoff, gbase, voff) do { _Pragma("unroll") for (int _i = 0; _i < 2; ++_i) \
        __builtin_amdgcn_global_load_lds((const unsigned*)((const char*)(gbase) + (voff)[_i]), (PG8_LAS unsigned*)(lds + (bufoff) + ldsw + _i * 8192), 16, 0, 0); } while (0)
#define PG8_LDA(dst, b, h) do { _Pragma("unroll") for (int m = 0; m < 4; ++m) _Pragma("unroll") for (int k = 0; k < 2; ++k) dst[m][k] = *(const PG8_LAS bf16x8*)(lds + PG8_SA(b, h) + aoff + m * 2048 + k * 1024); } while (0)
#define PG8_LDB(dst, b, h) do { _Pragma("unroll") for (int n = 0; n < 2; ++n) _Pragma("unroll") for (int k = 0; k < 2; ++k) dst[n][k] = *(const PG8_LAS bf16x8*)(lds + PG8_SB(b, h) + boff + n * 2048 + k * 1024); } while (0)
#define PG8_MMA(ai, bj, At, Bt) do { __builtin_amdgcn_s_setprio(1); _Pragma("unroll") for (int m = 0; m < 4; ++m) _Pragma("unroll") for (int n = 0; n < 2; ++n) _Pragma("unroll") for (int k = 0; k < 2; ++k) \
        acc[ai][bj][m][n] = __builtin_amdgcn_mfma_f32_16x16x32_bf16(Bt[n][k], At[m][k], acc[ai][bj][m][n], 0, 0, 0); __builtin_amdgcn_s_setprio(0); } while (0)
#define PG8_WAIT_V(n) asm volatile("s_waitcnt vmcnt(" #n ")" ::: "memory")
#define PG8_WAIT_L(n) asm volatile("s_waitcnt lgkmcnt(" #n ")" ::: "memory")
#define PG8_BAR __builtin_amdgcn_s_barrier()
#define PG8_SCHED __builtin_amdgcn_sched_barrier(0)
    Unit cur, nxt; int ui = 0;
    if (!S.next(0, cur)) return;
    f32x4 acc[2][2][4][2];
#pragma unroll
    for (int a = 0; a < 2; ++a)
#pragma unroll
        for (int b = 0; b < 2; ++b)
#pragma unroll
            for (int m = 0; m < 4; ++m)
#pragma unroll
                for (int n = 0; n < 2; ++n) acc[a][b][m][n] = (f32x4){0.f, 0.f, 0.f, 0.f};
    bf16x8 At[4][2], B0[2][2], B1[2][2];
    const char* cA = (const char*)g.A + (size_t)cur.pm * tstep; const char* cB = (const char*)g.Bt + (size_t)cur.pn * tstep;
    if constexpr (HET) { cA = S.abase(cur) + (size_t)cur.pm * tstep; cB = S.bbase(cur) + (size_t)cur.pn * tstep; nt = S.nt(cur); }
    S.a_ready(cur);
    if constexpr (SP2) {
        PG8_STAGE(PG8_SB(0, 0), cB, voffB); PG8_STAGE(PG8_SB(0, 1), cB + hstep, voffB); PG8_STAGE(PG8_SA(0, 0), cA, voffA); PG8_STAGE(PG8_SA(0, 1), cA + hstep, voffA);
        if (wr == 1) PG8_BAR;
        PG8_WAIT_V(2); PG8_BAR;
        PG8_STAGE(PG8_SB(1, 0), cB + kstep, voffB); PG8_STAGE(PG8_SA(1, 0), cA + kstep, voffA); PG8_STAGE(PG8_SB(1, 1), cB + hstep + kstep, voffB);
        PG8_WAIT_V(6); PG8_BAR;
    } else {
        PG8_STAGE(PG8_SB(0, 0), cB, voffB); PG8_STAGE(PG8_SA(0, 0), cA, voffA); PG8_STAGE(PG8_SB(0, 1), cB + hstep, voffB); PG8_STAGE(PG8_SA(0, 1), cA + hstep, voffA);
        if (wr == 1) PG8_BAR;
        PG8_WAIT_V(4); PG8_BAR;
        PG8_STAGE(PG8_SB(1, 0), cB + kstep, voffB); PG8_STAGE(PG8_SA(1, 0), cA + kstep, voffA); PG8_STAGE(PG8_SB(1, 1), cB + hstep + kstep, voffB);
        PG8_WAIT_V(6); PG8_BAR;
    }
    for (;;) {
        const bool has_next = S.next(ui + 1, nxt);
        const char* nA = has_next ? (const char*)g.A + (size_t)nxt.pm * tstep : cA; const char* nB = has_next ? (const char*)g.Bt + (size_t)nxt.pn * tstep : cB;
        if constexpr (HET) { if (has_next) { nA = S.abase(nxt) + (size_t)nxt.pm * tstep; nB = S.bbase(nxt) + (size_t)nxt.pn * tstep; } }
        for (int t = 0; t < nt; t += 2) {
            const bool last = (t == nt - 2);
            const char* a1 = cA + (size_t)(t + 1) * kstep;
            const char* a2 = last ? nA : cA + (size_t)(t + 2) * kstep; const char* b2 = last ? nB : cB + (size_t)(t + 2) * kstep;
            const char* a3 = a2 + kstep; const char* b3 = b2 + kstep;
            if (last && has_next) S.a_ready(nxt);
            if constexpr (SP2) {
            PG8_LDB(B0, 0, 0); PG8_LDB(B1, 0, 1); PG8_SCHED; PG8_LDA(At, 0, 0); PG8_STAGE(PG8_SA(1, 1), a1 + hstep, voffA);
            PG8_WAIT_V(8); PG8_WAIT_L(0); PG8_BAR; PG8_MMA(0, 0, At, B0); PG8_MMA(0, 1, At, B1); PG8_BAR; PG8_SCHED;
            PG8_LDA(At, 0, 1); PG8_STAGE(PG8_SB(0, 0), b2, voffB); PG8_STAGE(PG8_SB(0, 1), b2 + hstep, voffB); PG8_STAGE(PG8_SA(0, 0), a2, voffA);
            PG8_WAIT_V(8); PG8_WAIT_L(0); PG8_BAR; PG8_MMA(1, 0, At, B0); PG8_MMA(1, 1, At, B1); PG8_BAR; PG8_SCHED;
            PG8_LDB(B0, 1, 0); PG8_LDB(B1, 1, 1); PG8_SCHED; PG8_LDA(At, 1, 0); PG8_STAGE(PG8_SA(0, 1), a2 + hstep, voffA);
            PG8_WAIT_V(8); PG8_WAIT_L(0); PG8_BAR; PG8_MMA(0, 0, At, B0); PG8_MMA(0, 1, At, B1); PG8_BAR; PG8_SCHED;
            PG8_LDA(At, 1, 1); PG8_STAGE(PG8_SB(1, 0), b3, voffB); PG8_STAGE(PG8_SB(1, 1), b3 + hstep, voffB); PG8_STAGE(PG8_SA(1, 0), a3, voffA);
            PG8_WAIT_V(8); PG8_WAIT_L(0); PG8_BAR; PG8_MMA(1, 0, At, B0); PG8_MMA(1, 1, At, B1); PG8_BAR; PG8_SCHED;
            } else {
            PG8_LDB(B0, 0, 0); PG8_SCHED; PG8_LDA(At, 0, 0); PG8_STAGE(PG8_SA(1, 1), a1 + hstep, voffA);
            PG8_WAIT_L(8); PG8_BAR; PG8_WAIT_L(0); PG8_MMA(0, 0, At, B0); PG8_BAR; PG8_SCHED;
            PG8_LDB(B1, 0, 1); PG8_STAGE(PG8_SB(0, 0), b2, voffB);
            PG8_BAR; PG8_WAIT_L(0); PG8_MMA(0, 1, At, B1); PG8_BAR;
            PG8_LDA(At, 0, 1); PG8_STAGE(PG8_SA(0, 0), a2, voffA);
            PG8_BAR; PG8_WAIT_L(0); PG8_MMA(1, 0, At, B0); PG8_BAR; PG8_SCHED;
            PG8_STAGE(PG8_SB(0, 1), b2 + hstep, voffB);
            PG8_WAIT_V(6); PG8_BAR; PG8_MMA(1, 1, At, B1); PG8_BAR;
            PG8_LDB(B0, 1, 0); PG8_SCHED; PG8_LDA(At, 1, 0); PG8_STAGE(PG8_SA(0, 1), a2 + hstep, voffA);
            PG8_WAIT_L(8); PG8_BAR; PG8_WAIT_L(0); PG8_MMA(0, 0, At, B0); PG8_BAR; PG8_SCHED;
            PG8_LDB(B1, 1, 1); PG8_STAGE(PG8_SB(1, 0), b3, voffB);
            PG8_BAR; PG8_WAIT_L(0); PG8_MMA(0, 1, At, B1); PG8_BAR;
            PG8_LDA(At, 1, 1); PG8_STAGE(PG8_SA(1, 0), a3, voffA);
            PG8_BAR; PG8_WAIT_L(0); PG8_MMA(1, 0, At, B0); PG8_BAR; PG8_SCHED;
            PG8_STAGE(PG8_SB(1, 1), b3 + hstep, voffB);
            PG8_WAIT_V(6); PG8_BAR; PG8_MMA(1, 1, At, B1); PG8_BAR;
            }
        }
        if constexpr (ALIGN_EPI) { if (wr == 0) PG8_BAR; }
        if constexpr (!Epi::AFTER_DRAIN) { E(acc, cur, wr, wc, fr, fq); S.done(cur); }
        if (!has_next) break;
        bool clr = true; if constexpr (HET) clr = S.fresh(nxt);
        if (clr)
#pragma unroll
        for (int a = 0; a < 2; ++a)
#pragma unroll
            for (int b = 0; b < 2; ++b)
#pragma unroll
                for (int m = 0; m < 4; ++m)
#pragma unroll
                    for (int n = 0; n < 2; ++n) acc[a][b][m][n] = (f32x4){0.f, 0.f, 0.f, 0.f};
        cur = nxt; cA = nA; cB = nB; ++ui;
        if constexpr (HET) nt = S.nt(cur);
        if constexpr (ALIGN_EPI) { if (wr == 1) PG8_BAR; }
    }
    PG8_WAIT_V(0);
    if constexpr (!ALIGN_EPI) { if (wr == 0) PG8_BAR; }
    PG8_BAR;
    if constexpr (Epi::AFTER_DRAIN) { E.fused(acc, cur, wr, wc, fr, fq, lds, wid, lane); S.done(cur); }
#undef PG8_SA
#undef PG8_SB
#undef PG8_STAGE
#undef PG8_LDA
#undef PG8_LDB
#undef PG8_MMA
#undef PG8_WAIT_V
#undef PG8_WAIT_L
#undef PG8_BAR
#undef PG8_SCHED
}
}
#define GAS __attribute__((address_space(1)))
#define LAS __attribute__((address_space(3)))
typedef unsigned short bf16;
typedef unsigned v4u __attribute__((ext_vector_type(4)));
typedef float f32x4 __attribute__((ext_vector_type(4)));
typedef short bf16x8 __attribute__((ext_vector_type(8)));
typedef GAS unsigned gu32;
typedef GAS unsigned long long gu64;
#define RLX_AGENT __ATOMIC_RELAXED, __HIP_MEMORY_SCOPE_AGENT
#define LDS_WAIT() asm volatile("s_waitcnt lgkmcnt(0)" ::: "memory")
#define VM_WAIT() asm volatile("s_waitcnt vmcnt(0)" ::: "memory")
__device__ __forceinline__ unsigned long long rt() { return __builtin_amdgcn_s_memrealtime(); }
__device__ __forceinline__ unsigned f2bf(float f) { unsigned u = __builtin_bit_cast(unsigned, f); return (u + 0x7fffu + ((u >> 16) & 1u)) >> 16; }
__device__ __forceinline__ unsigned pk2(float lo, float hi) { return f2bf(lo) | (f2bf(hi) << 16); }

#define XB_TMO      128
#define XB_XCNT(j)  (256  + 64 * (j))
#define XB_XSUB(j)  (1280 + 64 * (j))
#define XB_XGEN(j)  (2304 + 64 * (j))
#define XB_TOP      3328
#define XB_TOPGEN   3392
#define XCD_BAR_WORDS 3456
#define XB_SPIN_CAP (1u << 18)

__device__ __forceinline__ unsigned xb_ld(unsigned* p)              { return __hip_atomic_load(p, __ATOMIC_RELAXED, __HIP_MEMORY_SCOPE_AGENT); }
__device__ __forceinline__ unsigned xb_add(unsigned* p, unsigned v) { return __hip_atomic_fetch_add(p, v, __ATOMIC_RELAXED, __HIP_MEMORY_SCOPE_AGENT); }
__device__ __forceinline__ unsigned xb_xcc_id() { return (unsigned)__builtin_amdgcn_s_getreg((3 << 11) | 20) & 0xFu; }
#define XB_SPIN(cond, bar) do { unsigned _sp = 0; while (cond) { __builtin_amdgcn_s_sleep(1); \
    if ((++_sp & 255u) == 0u) { if (xb_ld(&(bar)[XB_TMO])) break; if (_sp > XB_SPIN_CAP) { atomicAdd(&(bar)[XB_TMO], 1u); break; } } } } while (0)

struct XcdBarrier {
    unsigned* bar; unsigned x;
    volatile LAS unsigned* st;
};

__device__ __forceinline__ XcdBarrier xcd_barrier_post(unsigned* bar, volatile LAS unsigned* st) {
    XcdBarrier b; b.bar = bar; b.x = xb_xcc_id(); b.st = st;
    if (threadIdx.x == 0) (void)xb_add(&bar[XB_XCNT(b.x)], 1u);
    return b;
}
__device__ __forceinline__ void xcd_barrier_complete(unsigned* bar, unsigned x, unsigned& nloc, unsigned& nx) {
    const unsigned G = gridDim.x * gridDim.y * gridDim.z;
    unsigned sum, cnt, mine, sp = 0u;
    for (;;) {
        sum = 0u; cnt = 0u; mine = 0u;
#pragma unroll
        for (unsigned j = 0; j < 16; ++j) { const unsigned c = xb_ld(&bar[XB_XCNT(j)]); sum += c; cnt += (c > 0u) ? 1u : 0u; mine = (j == x) ? c : mine; }
        if (sum == G) break;
        __builtin_amdgcn_s_sleep(1);
        if ((++sp & 255u) == 0u) { if (xb_ld(&bar[XB_TMO])) break; if (sp > XB_SPIN_CAP) { atomicAdd(&bar[XB_TMO], 1u); break; } }
    }
    nloc = mine > 0u ? mine : 1u; nx = cnt > 0u ? cnt : 1u;
}

__device__ __forceinline__ void xcd_barrier(const XcdBarrier& b) {
    asm volatile("s_waitcnt vmcnt(0)" ::: "memory");
    __syncthreads();
    if (threadIdx.x == 0) {
        unsigned* bar = b.bar;
        __builtin_amdgcn_s_waitcnt(0);
        unsigned nloc = b.st[0], nx = b.st[1];
        if (nloc == 0u) { xcd_barrier_complete(bar, b.x, nloc, nx); b.st[0] = nloc; b.st[1] = nx; }
        const unsigned old = xb_add(&bar[XB_XSUB(b.x)], 1u);
        const unsigned gen = old / nloc;
        if (old + 1u == (gen + 1u) * nloc) {
            __builtin_amdgcn_fence(__ATOMIC_RELEASE, "agent");
            asm volatile("s_waitcnt vmcnt(0)" ::: "memory");
            const unsigned og = xb_add(&bar[XB_TOP], 1u);
            const unsigned tg = og / nx;
            if (og + 1u == (tg + 1u) * nx) xb_add(&bar[XB_TOPGEN], 1u);
            else XB_SPIN(xb_ld(&bar[XB_TOPGEN]) == tg, bar);
            __builtin_amdgcn_fence(__ATOMIC_ACQUIRE, "agent");
            xb_add(&bar[XB_XGEN(b.x)], 1u);
            asm volatile("s_waitcnt vmcnt(0)" ::: "memory");
        } else {
            XB_SPIN(xb_ld(&bar[XB_XGEN(b.x)]) == gen, bar);
            __builtin_amdgcn_fence(__ATOMIC_ACQUIRE, "agent");
            asm volatile("s_waitcnt vmcnt(0)" ::: "memory");
        }
    }
    __syncthreads();
}
constexpr int NWAVES = 8;
constexpr int RING_BYTES = 131072;
constexpr int LDSCTL_OFF = 155648 - 512, MISC_OFF = LDSCTL_OFF + 320;
constexpr int DSA_X_OFF = 139264;
constexpr int LDS_BYTES = 155648;
static_assert(DSA_X_OFF + 8 * 1024 + 8 * 512 <= LDS_BYTES - 512, "LDS map");
constexpr int NSTEPS = NL * 13 + 1;


struct Frame {
    LAS unsigned char* lds;
    volatile LAS unsigned* MISC;
    gu32* ctl;
    int tid, lane, wave, G, bid;
    unsigned char* ws;
    size_t prow;
};
__device__ __forceinline__ float bf2f(unsigned short b) { return __uint_as_float((unsigned)b << 16); }
#define pk2(lo_, hi_) pg8::cvt_pk_bf16((lo_), (hi_))
__device__ __forceinline__ float wave_sum(float v) {
#pragma unroll
    for (int o = 32; o >= 1; o >>= 1) v += __shfl_xor(v, o);
    return v;
}
__device__ __forceinline__ float wave_max(float v) {
#pragma unroll
    for (int o = 32; o >= 1; o >>= 1) v = fmaxf(v, __shfl_xor(v, o));
    return v;
}
__device__ __forceinline__ float silu_f(float x) { return x * __builtin_amdgcn_rcpf(1.0f + __expf(-x)); }
constexpr unsigned RS = 272;
typedef short s16x4 __attribute__((ext_vector_type(4)));
typedef short v4i16_t __attribute__((ext_vector_type(4)));
#define WAVE_LDS_FENCE() do { asm volatile("s_waitcnt lgkmcnt(0)" ::: "memory"); __builtin_amdgcn_wave_barrier(); asm volatile("" ::: "memory"); } while (0)

__device__ __forceinline__ int src_in(int r) {
    if (r < 2560) return r;
    if (r < 3072) return 2576 + (r - 2560);
    if (r < 3200) return 3088 + (r - 3072);
    if (r < 3328) return 3216 + (r - 3200);
    if (r < 3584) return 3344 + (r - 3328);
    if (r < 4096) return 3668 + (r - 3584);
    if (r < 7168) return 4180 + (r - 4096);
    if (r < 7232) return 3600 + (r - 7168);
    if (r < 7248) return 2560 + (r - 7232);
    if (r < 7252) return 3664 + (r - 7248);
    return -1;
}
__device__ __forceinline__ int src_ffi(int r) { const int t = r >> 8, w = r & 255; return w < 128 ? t * 128 + w : FFH + t * 128 + (w - 128); }
template <int MODE>
__device__ __forceinline__ void cvt_item(const float* W, int ldw, int K, int Ndst, bf16* WT, LAS float* scr, int item, int tid, const float* kg) {
    const int nblk = Ndst / 256, kb = item / nblk, nb = item % nblk, k0 = 64 * kb, r0 = 256 * nb;
    const int n4 = 4 * (tid & 63), rsub = tid >> 6;
    const int sc = MODE == 1 ? src_in(r0 + n4) : MODE == 2 ? src_ffi(r0 + n4) : r0 + n4;
    f32x4 v[8];
#pragma unroll
    for (int i = 0; i < 8; ++i) v[i] = sc >= 0 ? *(const f32x4*)(W + (size_t)(k0 + 8 * i + rsub) * ldw + sc) : (f32x4){0.f, 0.f, 0.f, 0.f};
#pragma unroll
    for (int i = 0; i < 8; ++i) { const int kk = 8 * i + rsub; const float gk = kg ? kg[k0 + kk] : 1.0f; LAS float* d = scr + kk * 257 + n4; d[0] = v[i].x * gk; d[1] = v[i].y * gk; d[2] = v[i].z * gk; d[3] = v[i].w * gk; }
    __syncthreads();
#pragma unroll
    for (int j = 0; j < 4; ++j) { const int idx = tid + 512 * j, nn = idx >> 3, c = idx & 7; const LAS float* sp = scr + (8 * c) * 257 + nn;
        v4u o; o.x = pk2(sp[0 * 257], sp[1 * 257]); o.y = pk2(sp[2 * 257], sp[3 * 257]); o.z = pk2(sp[4 * 257], sp[5 * 257]); o.w = pk2(sp[6 * 257], sp[7 * 257]);
        *(GAS v4u*)(WT + (size_t)(r0 + nn) * K + k0 + 8 * c) = o; }
    __syncthreads();
}
struct LayerW { const float *w_in, *w_us, *w_ua, *w_up, *w_out, *w_fi, *w_fo, *pool_w, *pool_scale, *g_n1, *g_ssd, *g_n2; };
__device__ __forceinline__ void phase_convert(Frame& F, const LayerW& W) {
    LAS float* scr = (LAS float*)(F.lds);
    constexpr int I_IN = (D / 64) * (INW_PAD / 256), I_US = (D / 64) * (D / 256), I_UA = (512 / 64) * (D / 256), I_OUT = I_US, I_FI = (D / 64) * (2 * FFH / 256), I_FO = (FFH / 64) * (D / 256);
    constexpr int NITEMS = I_IN + I_US + I_UA + I_OUT + I_FI + I_FO;
    for (int it = F.bid; it < NITEMS; it += F.G) {
        int r = it;
        if (r < I_IN) { cvt_item<1>(W.w_in, INW, D, INW_PAD, (bf16*)(F.ws + WS_WIN), scr, r, F.tid, W.g_n1); continue; } r -= I_IN;
        if (r < I_US) { cvt_item<0>(W.w_us, D, D, D, (bf16*)(F.ws + WS_WUS), scr, r, F.tid, W.g_ssd); continue; } r -= I_US;
        if (r < I_UA) { cvt_item<0>(W.w_ua, D, 1024, D, (bf16*)(F.ws + WS_WUA), scr, r, F.tid, nullptr); continue; } r -= I_UA;
        if (r < I_OUT) { cvt_item<0>(W.w_out, D, D, D, (bf16*)(F.ws + WS_WOUT), scr, r, F.tid, nullptr); continue; } r -= I_OUT;
        if (r < I_FI) { cvt_item<2>(W.w_fi, 2 * FFH, D, 2 * FFH, (bf16*)(F.ws + WS_WFI), scr, r, F.tid, W.g_n2); continue; } r -= I_FI;
        cvt_item<0>(W.w_fo, D, FFH, D, (bf16*)(F.ws + WS_WFO), scr, r, F.tid, nullptr);
    }
    bf16* WC = (bf16*)(F.ws + WS_WUA) + 512;
    LAS float* Al = (LAS float*)(F.lds); LAS float* red = (LAS float*)(F.lds + 4096);
    for (int u = F.bid; u < 256; u += F.G) {
        const int kc0 = 4 * (u >> 1), g = kc0 >> 7, c0 = kc0 & 127, dq = F.tid >> 7, tl = F.tid & 127, n4 = (u & 1) * 512 + tl * 4;
        { const int i = F.tid >> 7, d = F.tid & 127; Al[d * 4 + i] = W.pool_w[((size_t)g * 128 + c0 + i) * 128 + d] * W.pool_scale[g * 128 + d]; }
        const float* up = W.w_up + (size_t)(g * 128 + dq * 32) * D + n4;
        f32x4 uv[32];
#pragma unroll
        for (int dd = 0; dd < 32; ++dd) uv[dd] = *(const f32x4*)(up + (size_t)dd * D);
        __syncthreads();
        f32x4 acc[4];
#pragma unroll
        for (int i = 0; i < 4; ++i) acc[i] = (f32x4){0.f, 0.f, 0.f, 0.f};
#pragma unroll
        for (int dd = 0; dd < 32; ++dd) { const f32x4 a = *(const LAS f32x4*)(Al + (dq * 32 + dd) * 4);
#pragma unroll
            for (int i = 0; i < 4; ++i) acc[i] += a[i] * uv[dd]; }
#pragma unroll
        for (int i = 0; i < 4; ++i) *(LAS f32x4*)(red + (dq * 128 + tl) * 16 + i * 4) = acc[i];
        __syncthreads();
        { const int j = F.tid >> 7; float r[4];
#pragma unroll
            for (int i = 0; i < 4; ++i) r[i] = (red[(0 * 128 + tl) * 16 + i * 4 + j] + red[(1 * 128 + tl) * 16 + i * 4 + j]) + (red[(2 * 128 + tl) * 16 + i * 4 + j] + red[(3 * 128 + tl) * 16 + i * 4 + j]);
            *(unsigned long long*)(WC + (size_t)((u & 1) * 512 + tl * 4 + j) * 1024 + kc0) = (unsigned long long)pk2(r[0], r[1]) | ((unsigned long long)pk2(r[2], r[3]) << 32); }
        __syncthreads();
    }
}
__device__ __forceinline__ void phase_prep(Frame& F, const float* __restrict__ src, bf16* __restrict__ dst, float* __restrict__ pss, int nrows) {
    const int gw = F.bid * NWAVES + F.wave, NGW = F.G * NWAVES;
    for (int m = gw; m < nrows; m += NGW) {
        const f32x4* xr = (const f32x4*)(src + (size_t)m * D) + F.lane;
        f32x4 v[4]; float s = 0.f;
#pragma unroll
        for (int j = 0; j < 4; ++j) { v[j] = xr[64 * j]; s += (v[j].x * v[j].x + v[j].y * v[j].y) + (v[j].z * v[j].z + v[j].w * v[j].w); }
        s = wave_sum(s);
        unsigned long long* o8 = (unsigned long long*)(dst + (size_t)m * D) + F.lane;
#pragma unroll
        for (int j = 0; j < 4; ++j) o8[64 * j] = (unsigned long long)pk2(v[j].x, v[j].y) | ((unsigned long long)pk2(v[j].z, v[j].w) << 32);
        if (F.lane < 4) pss[(size_t)m * 4 + F.lane] = F.lane == 0 ? s : 0.f;
    }
}
__device__ __forceinline__ void phase_final(Frame& F, const bf16* __restrict__ xn, const float* __restrict__ pss, const float* __restrict__ gain, float* __restrict__ out, int nrows) {
    const int gw = F.bid * NWAVES + F.wave, NGW = F.G * NWAVES;
    f32x4 g[4];
#pragma unroll
    for (int j = 0; j < 4; ++j) g[j] = ((const f32x4*)gain)[F.lane + 64 * j];
    for (int m = gw; m < nrows; m += NGW) {
        const float r = pg8::row_rstd(pss + (size_t)m * 4);
        const unsigned long long* x8 = (const unsigned long long*)(xn + (size_t)m * D) + F.lane;
        f32x4* o = (f32x4*)(out + (size_t)m * D) + F.lane;
#pragma unroll
        for (int j = 0; j < 4; ++j) { const unsigned long long v = x8[64 * j]; const unsigned lo = (unsigned)v, hi = (unsigned)(v >> 32);
            o[64 * j] = (f32x4){pg8::bf_lo(lo), pg8::bf_hi(lo), pg8::bf_lo(hi), pg8::bf_hi(hi)} * r * g[j]; }
    }
}
__device__ __forceinline__ void unpack8(const v4u x, float (&f)[8]) { f[0] = pg8::bf_lo(x.x); f[1] = pg8::bf_hi(x.x); f[2] = pg8::bf_lo(x.y); f[3] = pg8::bf_hi(x.y); f[4] = pg8::bf_lo(x.z); f[5] = pg8::bf_hi(x.z); f[6] = pg8::bf_lo(x.w); f[7] = pg8::bf_hi(x.w); }
__device__ __forceinline__ void phase_conv_own(Frame& F, const float* conv_w, const float* conv_b) {
    const bf16* __restrict__ XBC = (const bf16*)(F.ws + WS_XBC); bf16* __restrict__ XBCC = (bf16*)(F.ws + WS_XBCC);
    for (int u = F.bid; u < NBP * 64; u += F.G) {
        const int b_loc = u >> 6, ch = (u >> 1) & 31, g = u & 1;
        for (int it = F.tid; it < 8 * 96; it += NWAVES * 64) {
            const int blk = it / 96, cg = it % 96, c = cg < 64 ? g * 512 + cg * 8 : cg < 80 ? 1024 + g * 128 + (cg - 64) * 8 : 1280 + g * 128 + (cg - 80) * 8;
            const int t0 = ch * 128 + blk * 16, r0 = b_loc * T + t0;
            float w[4][8], bs[8];
#pragma unroll
            for (int k = 0; k < 4; ++k) { const f32x4 a = *(const f32x4*)(conv_w + k * 1536 + c), b = *(const f32x4*)(conv_w + k * 1536 + c + 4);
                w[k][0] = a.x; w[k][1] = a.y; w[k][2] = a.z; w[k][3] = a.w; w[k][4] = b.x; w[k][5] = b.y; w[k][6] = b.z; w[k][7] = b.w; }
            { const f32x4 a = *(const f32x4*)(conv_b + c), b = *(const f32x4*)(conv_b + c + 4); bs[0] = a.x; bs[1] = a.y; bs[2] = a.z; bs[3] = a.w; bs[4] = b.x; bs[5] = b.y; bs[6] = b.z; bs[7] = b.w; }
            v4u xr[19];
#pragma unroll
            for (int j = 0; j < 19; ++j) xr[j] = (j >= 3 || t0 > 0) ? *(const v4u*)(XBC + (size_t)(r0 - 3 + j) * 1536 + c) : (v4u){0u, 0u, 0u, 0u};
            float x0[8], x1[8], x2[8], x3[8];
            unpack8(xr[0], x0); unpack8(xr[1], x1); unpack8(xr[2], x2);
#pragma unroll
            for (int j = 0; j < 16; ++j) {
                unpack8(xr[j + 3], x3);
                float a[8];
#pragma unroll
                for (int i = 0; i < 8; ++i) a[i] = silu_f(bs[i] + w[0][i] * x0[i] + w[1][i] * x1[i] + w[2][i] * x2[i] + w[3][i] * x3[i]);
                v4u o; o.x = pk2(a[0], a[1]); o.y = pk2(a[2], a[3]); o.z = pk2(a[4], a[5]); o.w = pk2(a[6], a[7]);
                *(v4u*)(XBCC + (size_t)(r0 + j) * 1536 + c) = o;
#pragma unroll
                for (int i = 0; i < 8; ++i) { x0[i] = x1[i]; x1[i] = x2[i]; x2[i] = x3[i]; }
            }
        }
    }
}
template <int WIN, int NT> __device__ __forceinline__ void pool_item(const bf16* __restrict__ U, bf16* __restrict__ PO, int r0, int t0, int c) {
    v4u pre[WIN - 1], cur[NT];
#pragma unroll
    for (int i = 0; i < WIN - 1; ++i) pre[i] = (t0 - (WIN - 1) + i >= 0) ? *(const v4u*)(U + (size_t)(r0 - (WIN - 1) + i) * 512 + c) : (v4u){0u, 0u, 0u, 0u};
#pragma unroll
    for (int j = 0; j < NT; ++j) cur[j] = *(const v4u*)(U + (size_t)(r0 + j) * 512 + c);
    float s[8];
#pragma unroll
    for (int i = 0; i < 8; ++i) s[i] = 0.f;
#pragma unroll
    for (int i = 0; i < WIN - 1; ++i) { float f[8]; unpack8(pre[i], f);
#pragma unroll
        for (int k = 0; k < 8; ++k) s[k] += f[k]; }
#pragma unroll
    for (int j = 0; j < NT; ++j) {
        const int t = t0 + j, cnt = (t + 1) < WIN ? (t + 1) : WIN; const float ic = __builtin_amdgcn_rcpf((float)cnt);
        float f[8]; unpack8(cur[j], f);
#pragma unroll
        for (int k = 0; k < 8; ++k) s[k] += f[k];
        v4u o; o.x = pk2(s[0] * ic - f[0], s[1] * ic - f[1]); o.y = pk2(s[2] * ic - f[2], s[3] * ic - f[3]); o.z = pk2(s[4] * ic - f[4], s[5] * ic - f[5]); o.w = pk2(s[6] * ic - f[6], s[7] * ic - f[7]);
        *(v4u*)(PO + (size_t)(r0 + j) * 1024 + c) = o;
        float g[8]; unpack8(j - WIN + 1 >= 0 ? cur[j - WIN + 1 >= 0 ? j - WIN + 1 : 0] : pre[j < WIN - 1 ? j : 0], g);
#pragma unroll
        for (int k = 0; k < 8; ++k) s[k] -= g[k];
    }
}
__device__ __forceinline__ void phase_pool(Frame& F) {
    const bf16* __restrict__ U = (const bf16*)(F.ws + WS_U); bf16* __restrict__ PO = (bf16*)(F.ws + WS_YAP) + 512;
    if (F.wave < 4) return;
    const int grp = F.wave - 4, coct = F.lane & 15, bsub = F.lane >> 4, c = grp * 128 + coct * 8;
    for (int bq = F.bid; bq < MP / 64; bq += F.G) {
        const int blk = bq * 4 + bsub, r0 = blk * 16, t0 = r0 & (T - 1);
        if (grp == 0) pool_item<2, 16>(U, PO, r0, t0, c); else if (grp == 1) pool_item<4, 16>(U, PO, r0, t0, c); else if (grp == 2) pool_item<8, 16>(U, PO, r0, t0, c);
        else { pool_item<16, 8>(U, PO, r0, t0, c); pool_item<16, 8>(U, PO, r0 + 8, t0 + 8, c); }
    }
}
template <int CTRL> __device__ __forceinline__ int dpp0(int v) { return __builtin_amdgcn_update_dpp(0, v, CTRL, 0xf, 0xf, true); }
__device__ __forceinline__ unsigned wave_umax(unsigned v) {
    v = max(v, (unsigned)dpp0<0xB1>((int)v)); v = max(v, (unsigned)dpp0<0x4E>((int)v)); v = max(v, (unsigned)dpp0<0x141>((int)v)); v = max(v, (unsigned)dpp0<0x140>((int)v));
    return max(max((unsigned)__builtin_amdgcn_readlane((int)v, 0), (unsigned)__builtin_amdgcn_readlane((int)v, 16)), max((unsigned)__builtin_amdgcn_readlane((int)v, 32), (unsigned)__builtin_amdgcn_readlane((int)v, 48)));
}
__device__ __forceinline__ unsigned wave_umin(unsigned v) { return ~wave_umax(~v); }
__device__ __forceinline__ int wave_suffix_sum(int x, int lane) {
    int p = x; p += dpp0<0x111>(p); p += dpp0<0x112>(p); p += dpp0<0x114>(p); p += dpp0<0x118>(p);
    const int t0 = __builtin_amdgcn_readlane(p, 15), t1 = __builtin_amdgcn_readlane(p, 31), t2 = __builtin_amdgcn_readlane(p, 47), t3 = __builtin_amdgcn_readlane(p, 63);
    const int r = lane >> 4, trow = r == 0 ? t0 : r == 1 ? t1 : r == 2 ? t2 : t3, tabove = r == 0 ? t1 + t2 + t3 : r == 1 ? t2 + t3 : r == 2 ? t3 : 0;
    return trow - p + x + tabove;
}
__device__ __forceinline__ unsigned f2key(float f) { const unsigned u = __float_as_uint(f); return (u & 0x80000000u) ? ~u : (u | 0x80000000u); }
__device__ __forceinline__ int mbcnt64(unsigned long long m) { return (int)__builtin_amdgcn_mbcnt_hi((unsigned)(m >> 32), __builtin_amdgcn_mbcnt_lo((unsigned)m, 0u)); }
typedef float f32x16 __attribute__((ext_vector_type(16)));
struct DsaQ { bf16x8 aq[4]; };
__device__ __forceinline__ void dsa_load_q(Frame& F, int b_loc, int t0, DsaQ& Qn) {
    int lane_ = F.lane; asm volatile("" : "+v"(lane_)); const int lane = lane_;
    const bf16* QI = (const bf16*)(F.ws + WS_QI);
    const size_t rowb = (size_t)b_loc * T; const int r = lane & 31, hh = lane >> 5;
#pragma unroll
    for (int s = 0; s < 4; ++s) Qn.aq[s] = *(const bf16x8*)(QI + (rowb + t0 + (r >> 2)) * 256 + (r & 3) * 64 + 16 * s + 8 * hh);
}
__device__ __forceinline__ void dsa_scores(Frame& F, int b_loc, int t0, const DsaQ& Qc) {
    int lane_ = F.lane; asm volatile("" : "+v"(lane_)); const int lane = lane_;
    const size_t rowb = (size_t)b_loc * T;
    const int r = lane & 31, hh = lane >> 5;
    bf16x8 aq[4];
#pragma unroll
    for (int s = 0; s < 4; ++s) aq[s] = Qc.aq[s];
    float wq[4][4];
#pragma unroll
    for (int a = 0; a < 4; ++a) { const uint2 wr = *(const uint2*)((const bf16*)(F.ws + WS_MISC) + (F.prow + rowb + t0 + 2 * a + hh) * 256 + 80);
        wq[a][0] = pg8::bf_lo(wr.x) * 0.0625f; wq[a][1] = pg8::bf_hi(wr.x) * 0.0625f; wq[a][2] = pg8::bf_lo(wr.y) * 0.0625f; wq[a][3] = pg8::bf_hi(wr.y) * 0.0625f; }
    const int ntile = 2 * ((t0 + 8 + 63) >> 6);
    const bf16* KI = (const bf16*)(F.ws + WS_KI) + (F.prow + rowb + r) * 64 + 8 * hh;
    bf16x8 kb[4][4];
#define DSA_KBLOAD(j, tile_) do { _Pragma("unroll") for (int s = 0; s < 4; ++s) kb[j][s] = *(const bf16x8*)(KI + (size_t)(tile_) * 32 * 64 + 16 * s); } while (0)
#define DSA_TILE(j, tile_) do { const int key = (tile_) * 32 + r; f32x16 acc; _Pragma("unroll") for (int i = 0; i < 16; ++i) acc[i] = 0.f; \
        _Pragma("unroll") for (int s = 0; s < 4; ++s) acc = __builtin_amdgcn_mfma_f32_32x32x16_bf16(aq[s], kb[j][s], acc, 0, 0, 0); \
        if ((tile_) + 4 * NWAVES < ntile) DSA_KBLOAD(j, (tile_) + 4 * NWAVES); \
          \
        _Pragma("unroll") for (int a = 0; a < 4; ++a) { \
            const float sc = fmaxf(acc[4 * a + 0], 0.f) * wq[a][0] + fmaxf(acc[4 * a + 1], 0.f) * wq[a][1] + fmaxf(acc[4 * a + 2], 0.f) * wq[a][2] + fmaxf(acc[4 * a + 3], 0.f) * wq[a][3]; \
            ((LAS unsigned*)(F.lds + (2 * a + hh) * 16384))[key] = key <= t0 + 2 * a + hh ? f2key(sc) : 0u; } } while (0)
#pragma unroll
    for (int j = 0; j < 4; ++j) if ((int)F.wave + j * NWAVES < ntile) DSA_KBLOAD(j, F.wave + j * NWAVES);
    for (int tile = F.wave; tile < ntile; tile += 4 * NWAVES) {
        DSA_TILE(0, tile);
        if (tile + NWAVES < ntile) DSA_TILE(1, tile + NWAVES);
        if (tile + 2 * NWAVES < ntile) DSA_TILE(2, tile + 2 * NWAVES);
        if (tile + 3 * NWAVES < ntile) DSA_TILE(3, tile + 3 * NWAVES);
    }
#undef DSA_TILE
#undef DSA_KBLOAD
}
__device__ __forceinline__ void dsa_query(Frame& F, int b_loc, int t, bf16* YO) {
    int lane_ = F.lane; asm volatile("" : "+v"(lane_)); const int lane = lane_;
    LAS unsigned* srow = (LAS unsigned*)(F.lds + F.wave * 16384);
    LAS float* qs = (LAS float*)(F.lds + DSA_X_OFF + F.wave * 1024);
    LAS unsigned short* idxs = (LAS unsigned short*)(F.lds + DSA_X_OFF + 8 * 1024 + F.wave * 512);
    const bf16* KV = (const bf16*)(F.ws + WS_KV); const bf16* Q = (const bf16*)(F.ws + WS_Q);
    const size_t rowq = (size_t)b_loc * T + t, rowb = (size_t)b_loc * T;
    const int n = t + 1, k = n < 256 ? n : 256, nch = (n + 63) >> 6, npad = nch * 64;
#ifndef DSADUP
#define DSADUP 0
#endif
    unsigned thr = 0u; int need = 0;
    for (int rep_ = 0; rep_ <= ((DSADUP >> 1) & 1); ++rep_) {
    thr = 0u; need = 0;
    if (n > 256) {
        LAS unsigned* hist = (LAS unsigned*)qs;
        v4u kv[16];
#pragma unroll
        for (int i = 0; i < 16; ++i) { const int e = i * 256 + lane * 4; kv[i] = (v4u){0u, 0u, 0u, 0u}; if (i * 256 < npad) { if (e < npad) kv[i] = *(const LAS v4u*)(srow + e); } }
        unsigned kmn = 0xffffffffu, kmx = 0u;
#pragma unroll
        for (int i = 0; i < 16; ++i) if (i * 256 < npad) { const v4u v = kv[i];
            kmx = max(max(kmx, v.x), max(v.y, max(v.z, v.w)));
            kmn = min(min(kmn, v.x ? v.x : 0xffffffffu), min(v.y ? v.y : 0xffffffffu, min(v.z ? v.z : 0xffffffffu, v.w ? v.w : 0xffffffffu))); }
        kmx = wave_umax(kmx); kmn = wave_umin(kmn);
        unsigned lo = kmn; const unsigned range = kmx - kmn; unsigned win = range;
        int sh = range ? 32 - __builtin_clz(range) - 8 : 0; if (sh < 0) sh = 0;
        int krem = k;
        for (;;) {
            { v4u z4 = (v4u){0u, 0u, 0u, 0u}; asm volatile("" : "+v"(z4)); *(LAS v4u*)(hist + lane * 4) = z4; }
            WAVE_LDS_FENCE();
#pragma unroll
            for (int i = 0; i < 16; ++i) if (i * 256 < npad) { const v4u v = kv[i];
                const unsigned d0 = v.x - lo, d1 = v.y - lo, d2 = v.z - lo, d3 = v.w - lo;
                if (d0 <= win) (void)__hip_atomic_fetch_add(hist + (d0 >> sh), 1u, __ATOMIC_RELAXED, __HIP_MEMORY_SCOPE_WORKGROUP); if (d1 <= win) (void)__hip_atomic_fetch_add(hist + (d1 >> sh), 1u, __ATOMIC_RELAXED, __HIP_MEMORY_SCOPE_WORKGROUP);
                if (d2 <= win) (void)__hip_atomic_fetch_add(hist + (d2 >> sh), 1u, __ATOMIC_RELAXED, __HIP_MEMORY_SCOPE_WORKGROUP); if (d3 <= win) (void)__hip_atomic_fetch_add(hist + (d3 >> sh), 1u, __ATOMIC_RELAXED, __HIP_MEMORY_SCOPE_WORKGROUP); }
            WAVE_LDS_FENCE();
            const v4u hv = *(const LAS v4u*)(hist + lane * 4);
            const int tl = (int)(hv.x + hv.y + hv.z + hv.w); const int sfx = wave_suffix_sum(tl, lane);
            const int above = sfx - tl;
            const bool mine = above < krem && sfx >= krem;
            int bsel, babove, bcnt;
            { int c = above + (int)hv.w; if (c >= krem) { bsel = 3; babove = above; bcnt = (int)hv.w; }
              else { const int c2 = c + (int)hv.z; if (c2 >= krem) { bsel = 2; babove = c; bcnt = (int)hv.z; }
              else { const int c1 = c2 + (int)hv.y; if (c1 >= krem) { bsel = 1; babove = c2; bcnt = (int)hv.y; } else { bsel = 0; babove = c1; bcnt = (int)hv.x; } } } }
            const unsigned long long mm = __ballot(mine);
            const int src = mm ? (int)__builtin_ctzll(mm) : 0;
            const int bstar = 4 * src + __builtin_amdgcn_readlane(bsel, src), ab = __builtin_amdgcn_readlane(babove, src), cb = __builtin_amdgcn_readlane(bcnt, src);
            krem -= ab; lo += (unsigned)bstar << sh;
            if (cb == krem) { thr = lo - 1u; need = 0; break; }
            if (sh == 0) { thr = lo; need = krem; break; }
            win = (1u << sh) - 1u; sh = sh > 8 ? sh - 8 : 0;
        }
        if (need == 0) {
            int base = 0;
#pragma unroll
            for (int i = 0; i < 16; ++i) if (i * 256 < npad) { const v4u v = kv[i]; const int e = i * 256 + lane * 4;
                const bool c0 = v.x > thr, c1 = v.y > thr, c2 = v.z > thr, c3 = v.w > thr;
                const unsigned long long m0 = __ballot(c0), m1 = __ballot(c1), m2 = __ballot(c2), m3 = __ballot(c3);
                int pos = base + mbcnt64(m0) + mbcnt64(m1) + mbcnt64(m2) + mbcnt64(m3);
                if (c0) idxs[pos++] = (unsigned short)e; if (c1) idxs[pos++] = (unsigned short)(e + 1); if (c2) idxs[pos++] = (unsigned short)(e + 2); if (c3) idxs[pos] = (unsigned short)(e + 3);
                base += __builtin_popcountll(m0) + __builtin_popcountll(m1) + __builtin_popcountll(m2) + __builtin_popcountll(m3); }
        }
    }
    if (n <= 256 || need != 0) {
        int base = 0, eqseen = 0;
#pragma unroll 8
        for (int c = 0; c < nch; ++c) {
            const unsigned key = srow[c * 64 + lane]; const bool gt = key > thr, eq = key == thr;
            const unsigned long long eqm = __ballot(eq); const int eqrank = eqseen + mbcnt64(eqm);
            const bool inc = gt || (eq && eqrank < need);
            const unsigned long long im = __ballot(inc); const int pos = base + mbcnt64(im);
            if (inc) idxs[pos] = (unsigned short)(c * 64 + lane);
            base += __builtin_popcountll(im); eqseen += __builtin_popcountll(eqm);
        }
    }
    WAVE_LDS_FENCE();
    }
    for (int rep_ = ((DSADUP >> 2) & 1); rep_ >= 0; --rep_)
    {
        const int hc = lane & 15, g = lane >> 4;
        const bf16* Qr = Q + rowq * 512 + hc * 64 + 8 * g;
        const bf16x8 zf = (bf16x8){0, 0, 0, 0, 0, 0, 0, 0};
        bf16x8 bq[4];
        bq[0] = hc < 4 ? *(const bf16x8*)(Qr) : zf; bq[1] = hc < 4 ? *(const bf16x8*)(Qr + 32) : zf;
        bq[2] = (hc >= 4 && hc < 8) ? *(const bf16x8*)(Qr) : zf; bq[3] = (hc >= 4 && hc < 8) ? *(const bf16x8*)(Qr + 32) : zf;
        v4u il[8];
#pragma unroll
        for (int i = 0; i < 8; ++i) il[i] = *(const LAS v4u*)(idxs + 64 * g + 8 * i);
#define DSA_IDX(m) ((int)((((m) & 7) < 2 ? il[(m) >> 3].x : ((m) & 7) < 4 ? il[(m) >> 3].y : ((m) & 7) < 6 ? il[(m) >> 3].z : il[(m) >> 3].w) >> (16 * ((m) & 1))) & 0xffff)
        LAS unsigned char* ring = (LAS unsigned char*)srow;
#define DSA_DMA(gp, lp) __builtin_amdgcn_global_load_lds((const unsigned*)(gp), (LAS unsigned*)(lp), 16, 0, 0)
#define DSA_VMWAIT(n) asm volatile("s_waitcnt vmcnt(" #n ")" ::: "memory")
#define DSA_KISSUE(tl) do { _Pragma("unroll") for (int i = 0; i < 4; ++i) { const int ridx = 64 * g + 4 * (tl) + i < k ? DSA_IDX(4 * (tl) + i) : 0; \
            DSA_DMA(KV + (rowb + ridx) * 256 + 8 * (hc ^ (2 * ((4 * i + g) & 7))), ring + ((tl) & 3) * 4096 + i * 1024); } } while (0)
        f32x4 sc[16];
        DSA_KISSUE(0); DSA_KISSUE(1); DSA_KISSUE(2); DSA_KISSUE(3);
#pragma unroll
        for (int tl = 0; tl < 16; ++tl) {
            if (tl <= 12) DSA_VMWAIT(12); else if (tl == 13) DSA_VMWAIT(8); else if (tl == 14) DSA_VMWAIT(4); else DSA_VMWAIT(0);
            const LAS unsigned char* kt = ring + (tl & 3) * 4096 + hc * 256;
            bf16x8 ka[4];
#pragma unroll
            for (int ks = 0; ks < 4; ++ks) ka[ks] = *(const LAS bf16x8*)(kt + 16 * ((4 * ks + g) ^ (2 * (hc & 7))));
            f32x4 a = (f32x4){0.f, 0.f, 0.f, 0.f};
#pragma unroll
            for (int ks = 0; ks < 4; ++ks) a = __builtin_amdgcn_mfma_f32_16x16x32_bf16(ka[ks], bq[ks], a, 0, 0, 0);
            sc[tl] = a;
            asm volatile("s_waitcnt lgkmcnt(0)" ::: "memory");
            if (tl + 4 < 16) DSA_KISSUE(tl + 4);
        }
#undef DSA_KISSUE
#define DSA_VISSUE(c) do { _Pragma("unroll") for (int i = 0; i < 8; ++i) { const int ridx = 64 * g + 8 * (c) + i < k ? DSA_IDX(8 * (c) + i) : 0; \
            DSA_DMA(KV + (rowb + ridx) * 256 + 128 + 8 * (hc ^ (2 * ((4 * i + g) & 7))), ring + ((c) & 1) * 8192 + i * 1024); } } while (0)
        DSA_VISSUE(0); DSA_VISSUE(1);
        float mx = -INFINITY;
#pragma unroll
        for (int tl = 0; tl < 16; ++tl)
#pragma unroll
            for (int e = 0; e < 4; ++e) { const float v = (64 * e + 4 * tl + g) < k ? sc[tl][e] * 0.125f : -INFINITY; sc[tl][e] = v; mx = fmaxf(mx, v); }
        mx = fmaxf(mx, __shfl_xor(mx, 16)); mx = fmaxf(mx, __shfl_xor(mx, 32));
        float sum = 0.f;
#pragma unroll
        for (int tl = 0; tl < 16; ++tl)
#pragma unroll
            for (int e = 0; e < 4; ++e) { const float p = __expf(sc[tl][e] - mx); sc[tl][e] = p; sum += p; }
        sum += __shfl_xor(sum, 16); sum += __shfl_xor(sum, 32);
        const float inv = 1.0f / sum;
        bf16x8 pb[8];
#pragma unroll
        for (int c = 0; c < 8; ++c) { const unsigned p0 = pk2(sc[2 * c][0], sc[2 * c][1]), p1 = pk2(sc[2 * c][2], sc[2 * c][3]), p2 = pk2(sc[2 * c + 1][0], sc[2 * c + 1][1]), p3 = pk2(sc[2 * c + 1][2], sc[2 * c + 1][3]);
            pb[c][0] = (short)(p0 & 0xffff); pb[c][1] = (short)(p0 >> 16); pb[c][2] = (short)(p1 & 0xffff); pb[c][3] = (short)(p1 >> 16);
            pb[c][4] = (short)(p2 & 0xffff); pb[c][5] = (short)(p2 >> 16); pb[c][6] = (short)(p3 & 0xffff); pb[c][7] = (short)(p3 >> 16); }
        f32x4 o[8];
#pragma unroll
        for (int mt = 0; mt < 8; ++mt) o[mt] = (f32x4){0.f, 0.f, 0.f, 0.f};
        const unsigned q4 = (lane & 15) >> 2, p4 = lane & 3;
#pragma unroll
        for (int c = 0; c < 8; ++c) {
            if (c < 7) DSA_VMWAIT(8); else DSA_VMWAIT(0);
            const LAS unsigned char* Vimg = ring + (c & 1) * 8192;
#pragma unroll
            for (int mt = 0; mt < 8; ++mt) {
                const unsigned vo = 16 * ((2 * mt + (p4 >> 1)) ^ (2 * ((4 * g + q4) & 7))) + 8 * (p4 & 1);
                const s16x4 lo4 = __builtin_amdgcn_ds_read_tr16_b64_v4i16((LAS v4i16_t*)(Vimg + (4 * g + q4) * 256 + vo));
                const s16x4 hi4 = __builtin_amdgcn_ds_read_tr16_b64_v4i16((LAS v4i16_t*)(Vimg + (16 + 4 * g + q4) * 256 + vo));
                const bf16x8 va = (bf16x8){lo4.x, lo4.y, lo4.z, lo4.w, hi4.x, hi4.y, hi4.z, hi4.w};
                o[mt] = __builtin_amdgcn_mfma_f32_16x16x32_bf16(va, pb[c], o[mt], 0, 0, 0);
            }
            asm volatile("s_waitcnt lgkmcnt(0)" ::: "memory");
            if (c + 2 < 8) DSA_VISSUE(c + 2);
        }
#undef DSA_VISSUE
#undef DSA_VMWAIT
#undef DSA_DMA
#undef DSA_IDX
        if (hc < 8) {
            bf16* op = (rep_ ? (bf16*)(F.ws + WS_STATES) : YO) + rowq * 1024 + hc * 64 + 4 * g;
#pragma unroll
            for (int mt = 0; mt < 4; ++mt) { const f32x4 v = (hc < 4 ? o[mt] : o[4 + mt]) * inv;
                *(unsigned long long*)(op + 16 * mt) = (unsigned long long)pk2(v[0], v[1]) | ((unsigned long long)pk2(v[2], v[3]) << 32); }
        }
    }
}
__device__ __forceinline__ void dsa_unit(Frame& F, int i, int& b_loc, int& qb) {
    const long u = (long)F.bid + (long)F.G * i; const int r = (int)(u % 512);
    b_loc = (int)(u / 512);
    const int pi = (r & 255), pm = (b_loc & 1) ? 255 - pi : pi;
    qb = r < 256 ? pm : 511 - pm;
}
__device__ __forceinline__ void phase_dsa(Frame& F, bf16* YO, const float* conv_w, const float* conv_b) {
    const int nu = (int)(((long)NBP * 512 - F.bid + F.G - 1) / F.G);
    for (int i = 0; i < nu; ++i) {
        int b_loc, qb; dsa_unit(F, i, b_loc, qb);
        if (i == nu - 1) { phase_conv_own(F, conv_w, conv_b); phase_pool(F); asm volatile("s_waitcnt vmcnt(0)" ::: "memory"); }
        __syncthreads();
        for (int rep_ = 0; rep_ <= (DSADUP & 1); ++rep_) { DsaQ Qc; dsa_load_q(F, b_loc, qb * 8, Qc); dsa_scores(F, b_loc, qb * 8, Qc); }
        __syncthreads();
        dsa_query(F, b_loc, qb * 8 + F.wave, YO);
    }
}
__device__ __forceinline__ unsigned rr16(unsigned lane, unsigned rb, unsigned s) { return ((lane & 15) + 16 * rb) * RS + 64 * s + 16 * (lane >> 4); }
__device__ __forceinline__ unsigned tr16(unsigned lane, unsigned c, unsigned ks, unsigned t) { const unsigned g = lane >> 4, q = (lane & 15) >> 2, p = lane & 3; return (32 * ks + 8 * g + 4 * t + q) * RS + (16 * c + 4 * p) * 2; }
__device__ __forceinline__ bf16x8 rowfrag(LAS unsigned char* img, unsigned lane, unsigned rb, unsigned s) { return *(const LAS bf16x8*)(img + rr16(lane, rb, s)); }
__device__ __forceinline__ bf16x8 trfrag(LAS unsigned char* img, unsigned lane, unsigned c, unsigned ks) {
    const s16x4 lo = __builtin_amdgcn_ds_read_tr16_b64_v4i16((LAS v4i16_t*)(img + tr16(lane, c, ks, 0))), hi = __builtin_amdgcn_ds_read_tr16_b64_v4i16((LAS v4i16_t*)(img + tr16(lane, c, ks, 1)));
    return (bf16x8){lo.x, lo.y, lo.z, lo.w, hi.x, hi.y, hi.z, hi.w};
}
__device__ __forceinline__ float softplus_f(float x) { return x > 20.f ? x : log1pf(__expf(x)); }
__device__ __forceinline__ float ssd_tables(const bf16* MS, size_t row0, int h, float bias, float A, LAS float* acs, LAS float* dts, int lane) {
    const float dt0 = softplus_f(bf2f(MS[(row0 + 2 * lane) * 256 + 64 + h]) + bias), dt1 = softplus_f(bf2f(MS[(row0 + 2 * lane + 1) * 256 + 64 + h]) + bias);
    const float a0 = dt0 * A, a1 = dt1 * A; float s = a0 + a1;
#pragma unroll
    for (int o = 1; o < 64; o <<= 1) { const float t = __shfl_up(s, o); if (lane >= o) s += t; }
    const float ex = s - (a0 + a1);
    acs[2 * lane] = ex + a0; acs[2 * lane + 1] = ex + a0 + a1; dts[2 * lane] = dt0; dts[2 * lane + 1] = dt1;
    return __shfl(s, 63);
}
__device__ __forceinline__ void phase_ssd_states(Frame& F, const float* dt_bias, const float* a_log) {
    const bf16* XC = (const bf16*)(F.ws + WS_XBCC); const bf16* MS = (const bf16*)(F.ws + WS_MISC) + F.prow * 256; bf16* ST = (bf16*)(F.ws + WS_STATES); float* DEC = (float*)(F.ws + WS_DEC);
    const int tid = F.tid, lane = F.lane, w = F.wave;
    LAS unsigned char* Bs = F.lds;
    LAS unsigned char* Xi = F.lds + 128 * RS + (w >> 2) * (128 * RS);
    LAS float* acs = (LAS float*)(F.lds + DSA_X_OFF + w * 1024); LAS float* dts = acs + 128;
    for (int u = F.bid; u < NBP * 64; u += F.G) {
        const int b_loc = u >> 6, c = (u >> 1) & 31, g = u & 1, h = g * 8 + w;
        const size_t row0 = (size_t)b_loc * T + c * 128;
        const float A = -__expf(a_log[h]);
        __syncthreads();
        const float a_end = ssd_tables(MS, row0, h, dt_bias[h], A, acs, dts, lane);
#pragma unroll
        for (int i = 0; i < 4; ++i) { const int idx = tid + 512 * i, r = idx >> 4, ch = idx & 15;
            const v4u v = __builtin_nontemporal_load((const v4u*)(XC + (row0 + r) * 1536 + 1024 + g * 128 + ch * 8)); *(LAS v4u*)(Bs + r * RS + 16 * (ch)) = v; }
        asm volatile("s_waitcnt lgkmcnt(0)" ::: "memory"); __builtin_amdgcn_wave_barrier();
        bf16* sp = ST + ((size_t)((b_loc * 32 + c) * 16 + h)) * 8192;
        for (int ph = 0; ph < 2; ++ph) {
            if (ph) __syncthreads();
#pragma unroll
            for (int i = 0; i < 8; ++i) { const int idx = lane + 64 * i, r = idx >> 2, c4 = idx & 3;
                const v4u v = __builtin_nontemporal_load((const v4u*)(XC + (row0 + r) * 1536 + h * 64 + 32 * ph + c4 * 8));
                const float sc = dts[r] * __expf(a_end - acs[r]);
                v4u o; o.x = pk2(pg8::bf_lo(v.x) * sc, pg8::bf_hi(v.x) * sc); o.y = pk2(pg8::bf_lo(v.y) * sc, pg8::bf_hi(v.y) * sc); o.z = pk2(pg8::bf_lo(v.z) * sc, pg8::bf_hi(v.z) * sc); o.w = pk2(pg8::bf_lo(v.w) * sc, pg8::bf_hi(v.w) * sc);
                *(LAS v4u*)(Xi + r * RS + 16 * ((w & 3) * 4 + c4)) = o; }
            __syncthreads();
            f32x4 acc[8][2];
#pragma unroll
            for (int i = 0; i < 8; ++i) { acc[i][0] = (f32x4){0.f, 0.f, 0.f, 0.f}; acc[i][1] = (f32x4){0.f, 0.f, 0.f, 0.f}; }
#pragma unroll
            for (int ks = 0; ks < 4; ++ks) {
                const bf16x8 xb0 = trfrag(Xi, lane, (w & 3) * 2 + 0, ks), xb1 = trfrag(Xi, lane, (w & 3) * 2 + 1, ks);
#pragma unroll
                for (int i = 0; i < 8; ++i) { const bf16x8 a = trfrag(Bs, lane, i, ks);
                    acc[i][0] = __builtin_amdgcn_mfma_f32_16x16x32_bf16(a, xb0, acc[i][0], 0, 0, 0); acc[i][1] = __builtin_amdgcn_mfma_f32_16x16x32_bf16(a, xb1, acc[i][1], 0, 0, 0); }
            }
#pragma unroll
            for (int i = 0; i < 8; ++i)
#pragma unroll
                for (int j = 0; j < 2; ++j) { const int pp = 32 * ph + 16 * j + (lane & 15), n = 16 * i + 4 * (lane >> 4);
                    *(unsigned long long*)(sp + pp * 128 + n) = (unsigned long long)pk2(acc[i][j][0], acc[i][j][1]) | ((unsigned long long)pk2(acc[i][j][2], acc[i][j][3]) << 32); }
        }
        if (lane == 0) DEC[(b_loc * 32 + c) * 16 + h] = __expf(a_end);
    }
}
__device__ __forceinline__ void phase_ssd_scan(Frame& F) {
    bf16* ST = (bf16*)(F.ws + WS_STATES); const float* DEC = (const float*)(F.ws + WS_DEC);
    for (int gt = F.bid * (NWAVES * 64) + F.tid; gt < NBP * 16 * 2048; gt += F.G * NWAVES * 64) {
        const int bh = gt >> 11, e4 = gt & 2047, b_loc = bh >> 4, h = bh & 15;
        bf16* sp = ST + ((size_t)(b_loc * 32) * 16 + h) * 8192 + e4 * 4; const float* dp = DEC + (b_loc * 32) * 16 + h;
        float s0 = 0.f, s1 = 0.f, s2 = 0.f, s3 = 0.f;
#pragma unroll 8
        for (int c = 0; c < 32; ++c) {
            unsigned long long* q = (unsigned long long*)(sp + (size_t)c * 16 * 8192);
            const unsigned long long v = *q; const float d = dp[c * 16];
            *q = (unsigned long long)pk2(s0, s1) | ((unsigned long long)pk2(s2, s3) << 32);
            const unsigned lo = (unsigned)v, hi = (unsigned)(v >> 32);
            s0 = s0 * d + pg8::bf_lo(lo); s1 = s1 * d + pg8::bf_hi(lo); s2 = s2 * d + pg8::bf_lo(hi); s3 = s3 * d + pg8::bf_hi(hi);
        }
    }
}
__device__ __forceinline__ void phase_ssd_out(Frame& F, const float* dt_bias, const float* a_log, const float* d_skip, bf16* ZO) {
    const bf16* XC = (const bf16*)(F.ws + WS_XBCC); const bf16* MS = (const bf16*)(F.ws + WS_MISC) + F.prow * 256; const bf16* ST = (const bf16*)(F.ws + WS_STATES); const bf16* Z = (const bf16*)(F.ws + WS_Z); float* SSQ = (float*)(F.ws + WS_SSQ);
    const int tid = F.tid, lane = F.lane, w = F.wave;
    LAS unsigned char* Cs = F.lds;
    LAS unsigned char* Bs = F.lds + 128 * RS;
    LAS unsigned char* Xi = F.lds + 256 * RS + (w >> 1) * (64 * RS);
    static_assert(256 * RS + 4 * 64 * RS <= DSA_X_OFF, "SSD LDS map");
    LAS float* acs = (LAS float*)(F.lds + DSA_X_OFF + w * 1024); LAS float* dts = acs + 128;
    LAS float* sqp = (LAS float*)(F.lds + DSA_X_OFF + 8192);
    for (int u = F.bid; u < NBP * 64; u += F.G) {
        const int b_loc = u >> 6, c = (u >> 1) & 31, g = u & 1, h = g * 8 + w;
        const size_t row0 = (size_t)b_loc * T + c * 128;
        const float A = -__expf(a_log[h]), Dh = d_skip[h];
        __syncthreads();
        (void)ssd_tables(MS, row0, h, dt_bias[h], A, acs, dts, lane);
#pragma unroll
        for (int i = 0; i < 4; ++i) { const int idx = tid + 512 * i, r = idx >> 4, ch = idx & 15; const bf16* rp = XC + (row0 + r) * 1536 + g * 128 + ch * 8;
            const v4u vb = *(const v4u*)(rp + 1024), vc = *(const v4u*)(rp + 1280); *(LAS v4u*)(Bs + r * RS + 16 * (ch)) = vb; *(LAS v4u*)(Cs + r * RS + 16 * (ch)) = vc; }
        asm volatile("s_waitcnt lgkmcnt(0)" ::: "memory"); __builtin_amdgcn_wave_barrier();
#pragma unroll
        for (int i = 0; i < 8; ++i) { const int idx = lane + 64 * i, r = idx >> 3, c8 = idx & 7;
            const v4u v = *(const v4u*)(XC + (row0 + r) * 1536 + h * 64 + c8 * 8); const float sc = dts[r];
            v4u o; o.x = pk2(pg8::bf_lo(v.x) * sc, pg8::bf_hi(v.x) * sc); o.y = pk2(pg8::bf_lo(v.y) * sc, pg8::bf_hi(v.y) * sc); o.z = pk2(pg8::bf_lo(v.z) * sc, pg8::bf_hi(v.z) * sc); o.w = pk2(pg8::bf_lo(v.w) * sc, pg8::bf_hi(v.w) * sc);
            *(LAS v4u*)(Xi + r * RS + 16 * ((w & 1) * 8 + c8)) = o; }
        __syncthreads();
        {
            f32x4 cb[8];
#pragma unroll
            for (int i = 0; i < 8; ++i) cb[i] = (f32x4){0.f, 0.f, 0.f, 0.f};
#pragma unroll
            for (int ks = 0; ks < 4; ++ks) { const bf16x8 a = rowfrag(Bs, lane, w, ks);
#pragma unroll
                for (int i = 0; i < 8; ++i) if (i >= w) cb[i] = __builtin_amdgcn_mfma_f32_16x16x32_bf16(a, rowfrag(Cs, lane, i, ks), cb[i], 0, 0, 0); }
            __syncthreads();
#pragma unroll
            for (int i = 0; i < 8; ++i) if (i >= w) { const unsigned l = 16 * i + (lane & 15);
                *(LAS unsigned long long*)(Bs + l * RS + (16 * w + 4 * (lane >> 4)) * 2) = (unsigned long long)pk2(cb[i][0], cb[i][1]) | ((unsigned long long)pk2(cb[i][2], cb[i][3]) << 32); }
            __syncthreads();
        }
        LAS unsigned char* CB = Bs;
        const bf16* pv = ST + ((size_t)((b_loc * 32 + c) * 16 + h)) * 8192 + (lane & 15) * 128 + 8 * (lane >> 4);
        for (int hl = 0; hl < 2; ++hl) {
            f32x4 acc[4][4];
#pragma unroll
            for (int j = 0; j < 4; ++j)
#pragma unroll
                for (int ii = 0; ii < 4; ++ii) acc[j][ii] = (f32x4){0.f, 0.f, 0.f, 0.f};
#pragma unroll 1
            for (int ks = 0; ks < 4; ++ks) {
                bf16x8 pa[4];
#pragma unroll
                for (int j = 0; j < 4; ++j) pa[j] = *(const bf16x8*)(pv + j * 16 * 128 + 32 * ks);
#pragma unroll
                for (int ii = 0; ii < 4; ++ii) { const bf16x8 cf = rowfrag(Cs, lane, 4 * hl + ii, ks);
#pragma unroll
                    for (int j = 0; j < 4; ++j) acc[j][ii] = __builtin_amdgcn_mfma_f32_16x16x32_bf16(pa[j], cf, acc[j][ii], 0, 0, 0); }
            }
#pragma unroll
            for (int ii = 0; ii < 4; ++ii) { const float el = __expf(acs[16 * (4 * hl + ii) + (lane & 15)]);
#pragma unroll
                for (int j = 0; j < 4; ++j) acc[j][ii] = acc[j][ii] * el; }
#pragma unroll 1
            for (int ks = 0; ks < 2 + 2 * hl; ++ks) {
                {
                    if (ks == 2) {
                        __syncthreads();
#pragma unroll
                        for (int i = 0; i < 8; ++i) { const int idx = lane + 64 * i, r = idx >> 3, c8 = idx & 7;
                            const v4u v = *(const v4u*)(XC + (row0 + 64 + r) * 1536 + h * 64 + c8 * 8); const float sc = dts[64 + r];
                            v4u o; o.x = pk2(pg8::bf_lo(v.x) * sc, pg8::bf_hi(v.x) * sc); o.y = pk2(pg8::bf_lo(v.y) * sc, pg8::bf_hi(v.y) * sc); o.z = pk2(pg8::bf_lo(v.z) * sc, pg8::bf_hi(v.z) * sc); o.w = pk2(pg8::bf_lo(v.w) * sc, pg8::bf_hi(v.w) * sc);
                            *(LAS v4u*)(Xi + r * RS + 16 * ((w & 1) * 8 + c8)) = o; }
                        __syncthreads();
                    }
                    bf16x8 xa[4];
#pragma unroll
                    for (int j = 0; j < 4; ++j) xa[j] = trfrag(Xi, lane, (w & 1) * 4 + j, ks & 1);
                    const int s0 = 32 * ks + 8 * (lane >> 4);
                    const f32x4 as0 = *(const LAS f32x4*)(acs + s0), as1 = *(const LAS f32x4*)(acs + s0 + 4);
#pragma unroll
                    for (int ii = 0; ii < 4; ++ii) if (4 * hl + ii >= 2 * ks) {
                        const int l = 16 * (4 * hl + ii) + (lane & 15);
                        const bf16x8 cbv = rowfrag(CB, lane, 4 * hl + ii, ks);
                        const float al = acs[l], dd = Dh * __builtin_amdgcn_rcpf(dts[l]);
                        float m[8];
                        m[0] = bf2f((unsigned short)cbv[0]) * __expf(al - as0.x); m[1] = bf2f((unsigned short)cbv[1]) * __expf(al - as0.y); m[2] = bf2f((unsigned short)cbv[2]) * __expf(al - as0.z); m[3] = bf2f((unsigned short)cbv[3]) * __expf(al - as0.w);
                        m[4] = bf2f((unsigned short)cbv[4]) * __expf(al - as1.x); m[5] = bf2f((unsigned short)cbv[5]) * __expf(al - as1.y); m[6] = bf2f((unsigned short)cbv[6]) * __expf(al - as1.z); m[7] = bf2f((unsigned short)cbv[7]) * __expf(al - as1.w);
#pragma unroll
                        for (int jj = 0; jj < 8; ++jj) { const int sx = s0 + jj; m[jj] = sx < l ? m[jj] : (sx == l ? m[jj] + dd : 0.f); }
                        bf16x8 mf; { const unsigned p0 = pk2(m[0], m[1]), p1 = pk2(m[2], m[3]), p2 = pk2(m[4], m[5]), p3 = pk2(m[6], m[7]);
                            mf[0] = (short)(p0 & 0xffff); mf[1] = (short)(p0 >> 16); mf[2] = (short)(p1 & 0xffff); mf[3] = (short)(p1 >> 16); mf[4] = (short)(p2 & 0xffff); mf[5] = (short)(p2 >> 16); mf[6] = (short)(p3 & 0xffff); mf[7] = (short)(p3 >> 16); }
#pragma unroll
                        for (int j = 0; j < 4; ++j) acc[j][ii] = __builtin_amdgcn_mfma_f32_16x16x32_bf16(xa[j], mf, acc[j][ii], 0, 0, 0);
                    }
                }
            }
            unsigned long long zq[4][4];
#pragma unroll
            for (int ii = 0; ii < 4; ++ii)
#pragma unroll
                for (int j = 0; j < 4; ++j) zq[ii][j] = *(const unsigned long long*)(Z + (row0 + 16 * (4 * hl + ii) + (lane & 15)) * 1024 + h * 64 + 16 * j + 4 * (lane >> 4));
#pragma unroll
            for (int ii = 0; ii < 4; ++ii) { float q = 0.f;
#pragma unroll
                for (int j = 0; j < 4; ++j) { const size_t zi = (row0 + 16 * (4 * hl + ii) + (lane & 15)) * 1024 + h * 64 + 16 * j + 4 * (lane >> 4);
                    const unsigned long long zv = zq[ii][j]; const unsigned zl = (unsigned)zv, zh = (unsigned)(zv >> 32);
                    const float g0 = acc[j][ii][0] * silu_f(pg8::bf_lo(zl)), g1 = acc[j][ii][1] * silu_f(pg8::bf_hi(zl)), g2 = acc[j][ii][2] * silu_f(pg8::bf_lo(zh)), g3 = acc[j][ii][3] * silu_f(pg8::bf_hi(zh));
                    q += (g0 * g0 + g1 * g1) + (g2 * g2 + g3 * g3);
                    *(unsigned long long*)(ZO + zi) = (unsigned long long)pk2(g0, g1) | ((unsigned long long)pk2(g2, g3) << 32); }
                q += __shfl_xor(q, 16); q += __shfl_xor(q, 32);
                if (lane < 16) sqp[(16 * (4 * hl + ii) + lane) * 8 + w] = q; }
        }
        __syncthreads();
        if (tid < 128) { const f32x4 q0 = *(const LAS f32x4*)(sqp + tid * 8), q1 = *(const LAS f32x4*)(sqp + tid * 8 + 4); SSQ[(row0 + tid) * 2 + g] = ((q0.x + q0.y) + (q0.z + q0.w)) + ((q1.x + q1.y) + (q1.z + q1.w)); }
    }
}
struct Args { const float* in[19]; float* out; unsigned char* ws; int lo, hi; };
static_assert(sizeof(Args) == 21 * 8 + 8, "Args has no holes");
#define CAS __attribute__((address_space(4)))
struct ProjOrder {
    pg8::StaticOrder S; int extra;
    __device__ __forceinline__ void init(int G, int c, int extra_) { S.init(MP, 28 * 256, G, c); extra = extra_; }
    __device__ __forceinline__ bool next(int i, pg8::Unit& u) const {
        const long Lx = (long)i * S.G + S.c;
        if (Lx < S.nwg) return S.next(i, u);
        if (Lx >= S.nwg + extra) return false;
        u.pm = (int)(Lx - S.nwg); u.pn = 28; return true;
    }
    __device__ __forceinline__ void a_ready(const pg8::Unit&) const {}
    __device__ __forceinline__ void done(const pg8::Unit&) const {}
};
struct MergeOrder {
    pg8::StaticOrder S; const char *A0, *A1, *B0, *B1;
    __device__ __forceinline__ bool next(int i, pg8::Unit& u) const { if (!S.next(i / 3, u)) return false; u.br = i % 3; return true; }
    __device__ __forceinline__ int nt(const pg8::Unit& u) const { return u.br == 0 ? 16 : 8; }
    __device__ __forceinline__ const char* abase(const pg8::Unit& u) const { return u.br == 0 ? A0 : A1 + (u.br - 1) * 1024; }
    __device__ __forceinline__ const char* bbase(const pg8::Unit& u) const { return u.br == 0 ? B0 : B1 + (u.br - 1) * 1024; }
    __device__ __forceinline__ bool fresh(const pg8::Unit& u) const { return u.br == 0; }
    __device__ __forceinline__ void a_ready(const pg8::Unit&) const {}
    __device__ __forceinline__ void done(const pg8::Unit&) const {}
};
template <class Sched> __device__ __forceinline__ pg8::RstdTab make_rstd_tab(const Sched& S, const float* pss, LAS unsigned char* lds, int tid) {
    LAS float* tab = (LAS float*)(lds + DSA_X_OFF + 4096);
    int pmA = -1, pmB = -1; pg8::Unit u;
    for (int i = 0; S.next(i, u); ++i) { if (pmA < 0) pmA = u.pm; else if (u.pm != pmA && pmB < 0) pmB = u.pm; }
    const int pmT = tid < 256 ? pmA : pmB;
    if (pmT >= 0) tab[tid] = pg8::row_rstd(pss + (size_t)(pmT * 256 + (tid & 255)) * 4);
    __syncthreads();
    return pg8::RstdTab{tab, pmA, pmB, pss};
}
__device__ __forceinline__ const CAS Args* kargs() { const CAS Args* p = (const CAS Args*)__builtin_amdgcn_kernarg_segment_ptr(); asm volatile("" : "+s"(p)); return p; }
__device__ __forceinline__ Frame mkframe(const CAS Args* A, LAS unsigned char* lds) {
    Frame F; F.lds = lds; F.MISC = (volatile LAS unsigned*)(lds + MISC_OFF);
    int t_ = threadIdx.x; asm volatile("" : "+v"(t_));
    F.tid = t_; F.lane = t_ & 63; F.wave = __builtin_amdgcn_readfirstlane(t_ >> 6);
    F.G = gridDim.x; F.bid = blockIdx.x; F.ws = A->ws; F.ctl = (gu32*)(F.ws + WS_CTL); F.prow = 0;
    return F;
}
__global__ void __launch_bounds__(NWAVES * 64, 2) trunk_fwd(Args args) {
    extern __shared__ __attribute__((aligned(16))) unsigned char lds[];
    LAS unsigned char* const L = (LAS unsigned char*)lds;
    for (int u = threadIdx.x; u < (LDS_BYTES - LDSCTL_OFF) / 4; u += NWAVES * 64) ((LAS unsigned*)(L + LDSCTL_OFF))[u] = 0u;
    __syncthreads();
    { const CAS Args* A = kargs(); (void)xcd_barrier_post((unsigned*)(A->ws + WS_CTL) + 4096, (volatile LAS unsigned*)(L + MISC_OFF) + 8); }
    const int lo = args.lo, hi = args.hi;
#ifndef PHASE_MASK
#define PHASE_MASK 0x7ff
#endif
#define PH(k) (((PHASE_MASK) >> (k)) & 1)
#ifndef DUP_MASK
#define DUP_MASK 0
#endif
#define DUP(k) (((DUP_MASK) >> (k)) & 1)
#define RUN(s) (lo <= (s) && (s) < hi)
#define SEAM_ALWAYS() do { const CAS Args* A_ = kargs(); XcdBarrier bar_; bar_.bar = (unsigned*)(A_->ws + WS_CTL) + 4096; bar_.x = xb_xcc_id(); bar_.st = (volatile LAS unsigned*)(L + MISC_OFF) + 8; xcd_barrier(bar_); if (DUP(12)) xcd_barrier(bar_); } while (0)
#define SEAM(s) do { if (RUN(s) && RUN((s) + 1)) { const CAS Args* A_ = kargs(); XcdBarrier bar_; bar_.bar = (unsigned*)(A_->ws + WS_CTL) + 4096; bar_.x = xb_xcc_id(); bar_.st = (volatile LAS unsigned*)(L + MISC_OFF) + 8; xcd_barrier(bar_); if (DUP(12)) xcd_barrier(bar_); } } while (0)
    for (int l = 0; l < NL; ++l) {
        const int sb = l * 13;
        if (PH(0) && RUN(sb)) {
            const CAS Args* A = kargs(); Frame F = mkframe(A, L);
            LayerW W; W.w_in = A->in[2] + (size_t)l * D * INW; W.w_us = A->in[11] + (size_t)l * D * D; W.w_ua = A->in[12] + (size_t)l * 512 * D; W.w_up = A->in[13] + (size_t)l * 512 * D;
            W.w_out = A->in[14] + (size_t)l * D * D; W.w_fi = A->in[16] + (size_t)l * D * 2 * FFH; W.w_fo = A->in[17] + (size_t)l * FFH * D; W.pool_w = A->in[9] + (size_t)l * 4 * 128 * 128; W.pool_scale = A->in[10] + (size_t)l * 512; W.g_n1 = A->in[1] + (size_t)l * D; W.g_ssd = A->in[8] + (size_t)l * D; W.g_n2 = A->in[15] + (size_t)l * D;
            for (int rep = 0; rep <= DUP(0); ++rep) {
            phase_convert(F, W);
            if (l == 0) phase_prep(F, A->in[0], (bf16*)(F.ws + WS_XN), (float*)(F.ws + WS_PSS), M); }
        }
        SEAM(sb);
        for (int p = 0; p < NPASS; ++p) {
            const int s1 = sb + 1 + p * 5;
            if (PH(1) && RUN(s1)) {
                const CAS Args* A = kargs(); Frame F = mkframe(A, L); unsigned char* ws = F.ws;
                pg8::Gemm g{(const bf16*)(ws + WS_XN) + (size_t)p * MP * D, (const bf16*)(ws + WS_WIN), MP, INW_PAD, D}; ProjOrder S; S.init(F.G, F.bid, p == 0 ? M / 256 : 0);
                pg8::EpiProj E{ws, make_rstd_tab(S, (const float*)(ws + WS_PSS) + (size_t)p * MP * 4, F.lds, F.tid)};
                for (int rep = 0; rep <= DUP(1); ++rep) pg8::gemm_phase<pg8::EpiProj, ProjOrder, true, true>(F.lds, g, S, E);
            }
            SEAM(s1);
            if (PH(2) && RUN(s1 + 1)) {
                const CAS Args* A = kargs(); Frame F = mkframe(A, L); F.prow = (size_t)p * MP;
                phase_dsa(F, (bf16*)(F.ws + WS_YAP), A->in[3] + (size_t)l * 4 * 1536, A->in[4] + (size_t)l * 1536);
                __syncthreads();
                phase_ssd_states(F, A->in[5] + l * 16, A->in[6] + l * 16);
            }
            SEAM(s1 + 1);
#ifndef SSD_NAIVE
#ifndef SSDSUB
#define SSDSUB 7
#endif
            if (PH(3) && RUN(s1 + 2)) for (int rep = DUP(3); rep >= 0; --rep) {
                if (rep != DUP(3)) SEAM_ALWAYS();
                if (SSDSUB & 2) { const CAS Args* A = kargs(); Frame F = mkframe(A, L); phase_ssd_scan(F); }
                SEAM_ALWAYS();
                for (int r2 = DUP(15); r2 >= 0; --r2) { if (r2 != DUP(15)) SEAM_ALWAYS(); if (SSDSUB & 4) { const CAS Args* A = kargs(); Frame F = mkframe(A, L); F.prow = (size_t)p * MP; phase_ssd_out(F, A->in[5] + l * 16, A->in[6] + l * 16, A->in[7] + l * 16, (bf16*)(F.ws + ((rep || r2) ? WS_MERGED : WS_Z))); } }
            }
#endif
            SEAM(s1 + 2);
#ifndef MSUB
#define MSUB 7
#endif
            if (PH(5) && RUN(s1 + 3)) for (int rep = 0; rep <= DUP(5); ++rep) {
                const CAS Args* A = kargs(); Frame F = mkframe(A, L); unsigned char* ws = F.ws;
                pg8::Gemm g{(const bf16*)(ws + WS_Z), (const bf16*)(ws + WS_WUS), MP, D, D};
                MergeOrder S; S.S.init(MP, D, F.G, F.bid); S.A0 = (const char*)(ws + WS_Z); S.A1 = (const char*)(ws + WS_YAP); S.B0 = (const char*)(ws + WS_WUS); S.B1 = (const char*)(ws + WS_WUA);
                pg8::EpiMergeChain E{(const bf16*)(ws + WS_GATES), (bf16*)(ws + WS_MERGED), (const float*)(ws + WS_SSQ)};
                pg8::gemm_phase<pg8::EpiMergeChain, MergeOrder, true, true, true>(F.lds, g, S, E);
            }
            SEAM(s1 + 3);
            if (PH(6) && RUN(s1 + 4)) {
                const CAS Args* A = kargs(); Frame F = mkframe(A, L); unsigned char* ws = F.ws;
                pg8::Gemm g{(const bf16*)(ws + WS_MERGED), (const bf16*)(ws + WS_WOUT), MP, D, D}; pg8::StaticOrder S; S.init(MP, D, F.G, F.bid);
                pg8::EpiResid E{(bf16*)(ws + WS_XN) + (size_t)p * MP * D, (float*)(ws + WS_PSS) + (size_t)p * MP * 4, (LAS float*)(F.lds + DSA_X_OFF)};
                pg8::gemm_phase<pg8::EpiResid, pg8::StaticOrder, true, true>(F.lds, g, S, E);
            }
            if (p == NPASS - 1) SEAM(s1 + 4);
        }
        if (PH(8) && RUN(sb + 11)) {
            const CAS Args* A = kargs(); Frame F = mkframe(A, L); unsigned char* ws = F.ws;
            pg8::Gemm g{(const bf16*)(ws + WS_XN), (const bf16*)(ws + WS_WFI), M, 2 * FFH, D}; pg8::StaticOrder S; S.init(M, 2 * FFH, F.G, F.bid);
            pg8::EpiSwiGLU E{(bf16*)(ws + WS_ACT), FFH, make_rstd_tab(S, (const float*)(ws + WS_PSS), F.lds, F.tid)};
            for (int rep = 0; rep <= DUP(8); ++rep) pg8::gemm_phase<pg8::EpiSwiGLU, pg8::StaticOrder, true, true>(F.lds, g, S, E);
        }
        SEAM(sb + 11);
        if (PH(9) && RUN(sb + 12)) {
            const CAS Args* A = kargs(); Frame F = mkframe(A, L); unsigned char* ws = F.ws;
            pg8::Gemm g{(const bf16*)(ws + WS_ACT), (const bf16*)(ws + WS_WFO), M, D, FFH}; pg8::StaticOrder S; S.init(M, D, F.G, F.bid);
            pg8::EpiResid E{(bf16*)(ws + WS_XN), (float*)(ws + WS_PSS), (LAS float*)(F.lds + DSA_X_OFF)};
            pg8::gemm_phase<pg8::EpiResid, pg8::StaticOrder, true, true>(F.lds, g, S, E);
        }
        SEAM(sb + 12);
    }
    if (PH(10) && RUN(NL * 13)) { const CAS Args* A = kargs(); Frame F = mkframe(A, L); phase_final(F, (const bf16*)(F.ws + WS_XN), (const float*)(F.ws + WS_PSS), A->in[18], A->out, M); }
#undef RUN
#undef SEAM
}

#ifndef N_LAUNCH_SPLIT
#define N_LAUNCH_SPLIT 0
#endif
extern "C" void kernel_launch(void* const* d_in, const int* in_sizes, int n_in, void* d_out, int out_size, void* d_ws, size_t ws_size, hipStream_t stream) {
    static int grid = 0;
    if (grid == 0) {
        if (n_in != 19 || in_sizes[0] != M * D || out_size != M * D || ws_size < WS_END) { fprintf(stderr, "kernel_launch: unexpected shapes / workspace (n_in %d, in0 %d, out %d, ws %zu); nothing launched\n", n_in, n_in > 0 ? in_sizes[0] : -1, out_size, ws_size); grid = -1; return; }
        int dev = 0, cus = 0, per_cu = 0;
        if (hipGetDevice(&dev) != hipSuccess || hipDeviceGetAttribute(&cus, hipDeviceAttributeMultiprocessorCount, dev) != hipSuccess) { grid = -1; return; }
        if (hipFuncSetAttribute((const void*)trunk_fwd, hipFuncAttributeMaxDynamicSharedMemorySize, LDS_BYTES) != hipSuccess) { fprintf(stderr, "kernel_launch: hipFuncSetAttribute failed\n"); grid = -1; return; }
        if (hipOccupancyMaxActiveBlocksPerMultiprocessor(&per_cu, (const void*)trunk_fwd, NWAVES * 64, LDS_BYTES) != hipSuccess || per_cu < 1) { fprintf(stderr, "kernel_launch: occupancy query reports %d workgroups per CU\n", per_cu); }
        (void)hipGetLastError();
        grid = cus;
    }
    if (grid < 0) return;
    if (hipMemsetAsync((char*)d_ws + WS_CTL, 0, CTL_ZERO_BYTES, stream) != hipSuccess) return;
    Args a{};
    for (int i = 0; i < 19; ++i) a.in[i] = (const float*)d_in[i];
    a.out = (float*)d_out; a.ws = (unsigned char*)d_ws;
#if N_LAUNCH_SPLIT
    for (int s = 0; s < NSTEPS; ++s) { a.lo = s; a.hi = s + 1; hipLaunchKernelGGL(trunk_fwd, dim3(grid), dim3(NWAVES * 64), LDS_BYTES, stream, a); }
#else
    a.lo = 0; a.hi = NSTEPS; hipLaunchKernelGGL(trunk_fwd, dim3(grid), dim3(NWAVES * 64), LDS_BYTES, stream, a);
#endif
}
```

```cpp
#include <hip/hip_runtime.h>
#include <cstdio>
#include <cstdint>

constexpr int NB = 8, T = 4096, D = 1024, NL = 4, M = NB * T;
constexpr int NBP = 4, MP = NBP * T, NPASS = NB / NBP;
constexpr int INW = 7252, INW_PAD = 7424, FFH = 2816;
constexpr float EPS = 1e-6f;
constexpr size_t MiB = 1u << 20;
constexpr size_t WS_CTL = 0, CTL_ZERO_BYTES = 1 * MiB;
constexpr size_t WS_WIN = 2 * MiB, WS_WUS = 17 * MiB, WS_WUA = 19 * MiB, WS_WUP = 20 * MiB, WS_WOUT = 21 * MiB, WS_WFI = 23 * MiB, WS_WFO = 34 * MiB;
constexpr size_t WS_XN = 40 * MiB;
constexpr size_t WS_Z = 104 * MiB, WS_XBC = 136 * MiB, WS_Q = 184 * MiB, WS_KV = 200 * MiB, WS_QI = 208 * MiB, WS_U = 216 * MiB,
                 WS_GATES = 240 * MiB, WS_XBCC = 336 * MiB, WS_YAP = 384 * MiB, WS_MISC = 416 * MiB, WS_STATES = 432 * MiB, WS_DEC = 464 * MiB, WS_SSQ = 465 * MiB, WS_PSS = 466 * MiB, WS_KI = 468 * MiB, WS_MERGED = 472 * MiB, WS_END = 504 * MiB;
constexpr size_t WS_ACT = 104 * MiB;
static_assert(WS_ACT + (size_t)M * FFH * 2 <= WS_STATES, "ACT overlay");
namespace pg8 {
#define PG8_LAS __attribute__((address_space(3)))
typedef unsigned short bf16_t;
typedef short bf16x8 __attribute__((ext_vector_type(8)));
typedef float f32x4 __attribute__((ext_vector_type(4)));
typedef unsigned u32x4 __attribute__((ext_vector_type(4)));
constexpr int BM = 256, BK = 64, HALF = 128, HTB = HALF * BK * 2  , STAGE_BYTES = 8 * HTB, NXCD = 8, WGM = 8;

__host__ __device__ __forceinline__ int lds_byte(int r, int c) { const int st = (r >> 4) * 2 + (c >> 5), rr = r & 15, cc = c & 31, ob = rr * 64 + cc * 2; return st * 1024 + (ob ^ (((ob >> 9) & 1) << 5)); }
__host__ __device__ __forceinline__ void stage_rc(int b, int& R, int& C) { const int st = b / 1024, sb = b % 1024, swz = sb ^ (((sb >> 9) & 1) << 5); R = (st >> 1) * 16 + swz / 64; C = (st & 1) * 32 + (swz % 64) / 2; }
__host__ __device__ __forceinline__ int perm32(int rho) { const int n = rho >> 4, i = rho & 15; return 8 * (i >> 2) + 4 * n + (i & 3); }

struct Unit { int pm, pn, br; };
struct Gemm { const bf16_t* A; const bf16_t* Bt; int M, N, K; };

struct StaticOrder {
    int nM, nN, nwg, G, c;
    __host__ __device__ void init(int M, int N, int G_, int c_) { nM = M / BM; nN = N / BM; nwg = nM * nN; G = G_; c = c_; }
    __host__ __device__ bool next(int i, Unit& u) const {
        const long L = (long)i * G + c; if (L >= nwg) return false;
        int wgid = (int)L; { const int q = nwg / NXCD, r = nwg % NXCD, xcd = wgid % NXCD, off = wgid / NXCD; wgid = (xcd < r ? xcd * (q + 1) : r * (q + 1) + (xcd - r) * q) + off; }
        const int nig = WGM * nN, gid = wgid / nig, fm = gid * WGM, gsz = (nM - fm) < WGM ? (nM - fm) : WGM;
        u.pm = fm + ((wgid % nig) % gsz); u.pn = (wgid % nig) / gsz; return true;
    }
    __device__ __forceinline__ void a_ready(const Unit&) const {}
    __device__ __forceinline__ void done(const Unit&) const {}
};

__device__ __forceinline__ unsigned cvt_pk_bf16(float lo, float hi) { unsigned r; asm volatile("v_cvt_pk_bf16_f32 %0, %1, %2" : "=v"(r) : "v"(lo), "v"(hi)); return r; }
typedef float f32x2 __attribute__((ext_vector_type(2)));
__device__ __forceinline__ float bf_lo(unsigned w) { return __uint_as_float(w << 16); }
__device__ __forceinline__ float bf_hi(unsigned w) { return __uint_as_float(w & 0xffff0000u); }
__device__ __forceinline__ float sigm(float x) { return __builtin_amdgcn_rcpf(1.0f + __expf(-x)); }
__device__ __forceinline__ float row_rstd(const float* p4) { const f32x4 a = *(const f32x4*)p4; return __builtin_amdgcn_rsqf(((a[0] + a[1]) + (a[2] + a[3])) * (1.0f / 1024.0f) + 1e-6f); }
__device__ __forceinline__ float row_rstd2(const float* p2) { typedef float f32x2v __attribute__((ext_vector_type(2))); const f32x2v a = *(const f32x2v*)p2; return __builtin_amdgcn_rsqf((a[0] + a[1]) * (1.0f / 1024.0f) + 1e-6f); }

struct RstdTab { const PG8_LAS float* tab; int pmA, pmB; const float* pss;
    __device__ __forceinline__ float get(int pm, int rl) const { return pm == pmA ? tab[rl] : (pm == pmB ? tab[BM + rl] : row_rstd(pss + (size_t)(pm * BM + rl) * 4)); } };
struct EpiProj {
    static constexpr bool PERM = true, AFTER_DRAIN = false;
    unsigned char* ws; RstdTab rt;
    __device__ __forceinline__ void operator()(const f32x4 (&acc)[2][2][4][2], const Unit& u, int wr, int wc, int fr, int fq) const {
        const int pn = u.pn; size_t off; int ldc, c0;
        if (pn < 4)       { off = WS_Z;     ldc = 1024; c0 = pn * 256; }
        else if (pn < 10) { off = WS_XBC;   ldc = 1536; c0 = (pn - 4) * 256; }
        else if (pn < 12) { off = WS_Q;     ldc = 512;  c0 = (pn - 10) * 256; }
        else if (pn < 13) { off = WS_KV;    ldc = 256;  c0 = 0; }
        else if (pn < 14) { off = WS_QI;    ldc = 256;  c0 = 0; }
        else if (pn < 16) { off = WS_U;     ldc = 512;  c0 = (pn - 14) * 256; }
        else if (pn < 28) { off = WS_GATES; ldc = 3072; c0 = (pn - 16) * 256; }
        else              { off = WS_MISC;  ldc = 256;  c0 = 0; }
        bf16_t* base = (bf16_t*)(ws + off);
        const int row0 = u.pm * BM + wr * 64 + fr, col0 = c0 + wc * 32 + 8 * fq;
        float rsv[2][4];
#pragma unroll
        for (int ai = 0; ai < 2; ++ai)
#pragma unroll
            for (int m = 0; m < 4; ++m) rsv[ai][m] = rt.get(u.pm, wr * 64 + fr + ai * HALF + m * 16);
#pragma unroll
        for (int ai = 0; ai < 2; ++ai)
#pragma unroll
            for (int m = 0; m < 4; ++m) { const int row = row0 + ai * HALF + m * 16; bf16_t* rowp = base + (size_t)row * ldc + col0; const float rs = rsv[ai][m];
#pragma unroll
                for (int bj = 0; bj < 2; ++bj) { const f32x4 v0 = acc[ai][bj][m][0] * rs, v1 = acc[ai][bj][m][1] * rs;
                    u32x4 w; w.x = cvt_pk_bf16(v0[0], v0[1]); w.y = cvt_pk_bf16(v0[2], v0[3]); w.z = cvt_pk_bf16(v1[0], v1[1]); w.w = cvt_pk_bf16(v1[2], v1[3]);
                    if (pn == 28 && bj == 0 && wc < 2) *(u32x4*)((bf16_t*)(ws + WS_KI) + (size_t)row * 64 + col0) = w;
                    __builtin_nontemporal_store(w, (u32x4*)(rowp + bj * HALF));
#if defined(DUP_MASK) && ((DUP_MASK >> 13) & 1)
                    { const size_t o2 = ((size_t)((const char*)(rowp + bj * HALF) - (const char*)ws)) & (32 * MiB - 1); *(u32x4*)(ws + WS_STATES + o2) = w; }
#endif
                    } }
    }
};
struct EpiSwiGLU {
    static constexpr bool PERM = true, AFTER_DRAIN = false;
    bf16_t* O; int ldc; RstdTab rt;
    __device__ __forceinline__ void operator()(const f32x4 (&acc)[2][2][4][2], const Unit& u, int wr, int wc, int fr, int fq) const {
        const int row0 = u.pm * BM + wr * 64 + fr, col0 = u.pn * HALF + wc * 32 + 8 * fq;
        float rsv[2][4];
#pragma unroll
        for (int ai = 0; ai < 2; ++ai)
#pragma unroll
            for (int m = 0; m < 4; ++m) rsv[ai][m] = rt.get(u.pm, wr * 64 + fr + ai * HALF + m * 16);
#pragma unroll
        for (int ai = 0; ai < 2; ++ai)
#pragma unroll
            for (int m = 0; m < 4; ++m) { const int row = row0 + ai * HALF + m * 16; bf16_t* rowp = O + (size_t)row * ldc + col0; const float rs = rsv[ai][m];
                float r[8];
#pragma unroll
                for (int n = 0; n < 2; ++n)
#pragma unroll
                    for (int i = 0; i < 4; ++i) { const float a = acc[ai][0][m][n][i] * rs, b = acc[ai][1][m][n][i] * rs; r[n * 4 + i] = a * sigm(a) * b; }
                u32x4 w; w.x = cvt_pk_bf16(r[0], r[1]); w.y = cvt_pk_bf16(r[2], r[3]); w.z = cvt_pk_bf16(r[4], r[5]); w.w = cvt_pk_bf16(r[6], r[7]);
                *(u32x4*)rowp = w; }
    }
};
struct EpiResid {
    static constexpr bool PERM = true, AFTER_DRAIN = false;
    bf16_t* xn; float* pss; PG8_LAS float* part;
    __device__ __forceinline__ void operator()(const f32x4 (&acc)[2][2][4][2], const Unit& u, int wr, int wc, int fr, int fq) const {
        const int row0 = u.pm * BM + wr * 64 + fr, col0 = u.pn * BM + wc * 32 + 8 * fq;
#pragma unroll
        for (int ai = 0; ai < 2; ++ai) {
            u32x4 hw[4][2];
#pragma unroll
            for (int m = 0; m < 4; ++m)
#pragma unroll
                for (int bj = 0; bj < 2; ++bj) hw[m][bj] = *(const u32x4*)(xn + (size_t)(row0 + ai * HALF + m * 16) * 1024 + col0 + bj * HALF);
#pragma unroll
            for (int m = 0; m < 4; ++m) { bf16_t* rowp = xn + (size_t)(row0 + ai * HALF + m * 16) * 1024 + col0; float ss = 0.f;
#pragma unroll
                for (int bj = 0; bj < 2; ++bj) { const u32x4 h4 = hw[m][bj]; const f32x4 v0 = acc[ai][bj][m][0], v1 = acc[ai][bj][m][1];
                    float r[8];
                    r[0] = bf_lo(h4.x) + v0[0]; r[1] = bf_hi(h4.x) + v0[1]; r[2] = bf_lo(h4.y) + v0[2]; r[3] = bf_hi(h4.y) + v0[3];
                    r[4] = bf_lo(h4.z) + v1[0]; r[5] = bf_hi(h4.z) + v1[1]; r[6] = bf_lo(h4.w) + v1[2]; r[7] = bf_hi(h4.w) + v1[3];
                    ss += ((r[0] * r[0] + r[1] * r[1]) + (r[2] * r[2] + r[3] * r[3])) + ((r[4] * r[4] + r[5] * r[5]) + (r[6] * r[6] + r[7] * r[7]));
                    u32x4 w; w.x = cvt_pk_bf16(r[0], r[1]); w.y = cvt_pk_bf16(r[2], r[3]); w.z = cvt_pk_bf16(r[4], r[5]); w.w = cvt_pk_bf16(r[6], r[7]);
                    *(u32x4*)(rowp + bj * HALF) = w; }
                ss += __shfl_xor(ss, 16); ss += __shfl_xor(ss, 32);
                if (fq == 0) part[(ai * HALF + wr * 64 + m * 16 + fr) * 4 + wc] = ss; }
        }
        asm volatile("s_waitcnt lgkmcnt(0)" ::: "memory"); __builtin_amdgcn_s_barrier(); asm volatile("" ::: "memory");
        int t = threadIdx.x; asm volatile("" : "+v"(t));
        if (t < BM) { const f32x4 q = *(const PG8_LAS f32x4*)(part + t * 4); pss[(size_t)(u.pm * BM + t) * 4 + u.pn] = (q[0] + q[1]) + (q[2] + q[3]); }
    }
};
__device__ __forceinline__ float gclamp(float g) { return fminf(fmaxf(g, -30.f), 30.f); }
__device__ __forceinline__ float gratio(float gn, float gd) { return (1.0f + __expf(-gclamp(gd))) * __builtin_amdgcn_rcpf(1.0f + __expf(-gclamp(gn))); }
struct EpiMergeChain {
    static constexpr bool PERM = true, AFTER_DRAIN = false;
    const bf16_t* gates; bf16_t* P; const float* ssq;
    __device__ __forceinline__ void operator()(f32x4 (&acc)[2][2][4][2], const Unit& u, int wr, int wc, int fr, int fq) const {
        const int row0 = u.pm * BM + wr * 64 + fr, col0 = u.pn * BM + wc * 32 + 8 * fq;
        if (u.br < 2) {
            const bf16_t* gn = gates + u.br * 1024; const bool first = u.br == 0;
#pragma unroll
            for (int ai = 0; ai < 2; ++ai)
#pragma unroll
                for (int m = 0; m < 4; ++m) { const size_t row = (size_t)(row0 + ai * HALF + m * 16); const float rs = first ? row_rstd2(ssq + row * 2) : 1.0f;
#pragma unroll
                    for (int bj = 0; bj < 2; ++bj) { const u32x4 x = *(const u32x4*)(gn + row * 3072 + col0 + bj * HALF), y = *(const u32x4*)(gn + 1024 + row * 3072 + col0 + bj * HALF);
                        { const f32x4 r0 = (f32x4){gratio(bf_lo(x.x), bf_lo(y.x)), gratio(bf_hi(x.x), bf_hi(y.x)), gratio(bf_lo(x.y), bf_lo(y.y)), gratio(bf_hi(x.y), bf_hi(y.y))};
                          acc[ai][bj][m][0] = acc[ai][bj][m][0] * (r0 * rs); asm volatile("" : "+v"(acc[ai][bj][m][0])); }
                        { const f32x4 r1 = (f32x4){gratio(bf_lo(x.z), bf_lo(y.z)), gratio(bf_hi(x.z), bf_hi(y.z)), gratio(bf_lo(x.w), bf_lo(y.w)), gratio(bf_hi(x.w), bf_hi(y.w))};
                          acc[ai][bj][m][1] = acc[ai][bj][m][1] * (r1 * rs); asm volatile("" : "+v"(acc[ai][bj][m][1])); } }
                    asm volatile("" ::: "memory"); }
        } else {
            const bf16_t* g3 = gates + 2048;
#pragma unroll
            for (int ai = 0; ai < 2; ++ai)
#pragma unroll
                for (int m = 0; m < 4; ++m) { const size_t row = (size_t)(row0 + ai * HALF + m * 16);
#pragma unroll
                    for (int bj = 0; bj < 2; ++bj) { const u32x4 x = *(const u32x4*)(g3 + row * 3072 + col0 + bj * HALF); const f32x4 v0 = acc[ai][bj][m][0], v1 = acc[ai][bj][m][1];
                        u32x4 w; w.x = cvt_pk_bf16(v0[0] * sigm(gclamp(bf_lo(x.x))), v0[1] * sigm(gclamp(bf_hi(x.x)))); w.y = cvt_pk_bf16(v0[2] * sigm(gclamp(bf_lo(x.y))), v0[3] * sigm(gclamp(bf_hi(x.y))));
                        w.z = cvt_pk_bf16(v1[0] * sigm(gclamp(bf_lo(x.z))), v1[1] * sigm(gclamp(bf_hi(x.z)))); w.w = cvt_pk_bf16(v1[2] * sigm(gclamp(bf_lo(x.w))), v1[3] * sigm(gclamp(bf_hi(x.w))));
                        *(u32x4*)(P + row * 1024 + col0 + bj * HALF) = w; }
                    if (m & 1) asm volatile("" ::: "memory"); }
        }
    }
};

template <class Epi, class Sched, bool ALIGN_EPI = false, bool SP2 = false, bool HET = false>
__device__ __forceinline__ void gemm_phase(PG8_LAS unsigned char* lds, const Gemm g, const Sched& S, const Epi& E) {
    int tid_ = threadIdx.x; asm volatile("" : "+v"(tid_));
    const int tid = tid_, wid = __builtin_amdgcn_readfirstlane(tid >> 6), lane = tid & 63, wr = wid >> 2, wc = wid & 3, fr = lane & 15, fq = lane >> 4;
    const int K = g.K; int nt = K / BK;
    unsigned voffA[2], voffB[2];
#pragma unroll
    for (int i = 0; i < 2; ++i) { int R, C; stage_rc(tid * 16 + i * 8192, R, C); const int Rb = Epi::PERM ? ((R & ~31) + perm32(R & 31)) : R;
        voffA[i] = (unsigned)(R * K + C) * 2u; voffB[i] = (unsigned)(Rb * K + C) * 2u; }
    const size_t kstep = (size_t)(BK * 2);
    const size_t hstep = (size_t)HALF * K * 2;
    const size_t tstep = 2 * hstep;
    const unsigned ldsw = (unsigned)wid * 1024u;
    const int aoff = lds_byte(wr * 64 + fr, fq * 8), boff = lds_byte(wc * 32 + fr, fq * 8);
#define PG8_SA(b, h) (((b) * 2 + (h)) * HTB)
#define PG8_SB(b, h) ((4 + (b) * 2 + (h)) * HTB)
#define PG8_STAGE(bufoff, gbase, voff) do { _Pragma("unroll") for (int _i = 0; _i < 2; ++_i) \
        __builtin_amdgcn_global_load_lds((const unsigned*)((const char*)(gbase) + (voff)[_i]), (PG8_LAS unsigned*)(lds + (bufoff) + ldsw + _i * 8192), 16, 0, 0); } while (0)
#define PG8_LDA(dst, b, h) do { _Pragma("unroll") for (int m = 0; m < 4; ++m) _Pragma("unroll") for (int k = 0; k < 2; ++k) dst[m][k] = *(const PG8_LAS bf16x8*)(lds + PG8_SA(b, h) + aoff + m * 2048 + k * 1024); } while (0)
#define PG8_LDB(dst, b, h) do { _Pragma("unroll") for (int n = 0; n < 2; ++n) _Pragma("unroll") for (int k = 0; k < 2; ++k) dst[n][k] = *(const PG8_LAS bf16x8*)(lds + PG8_SB(b, h) + boff + n * 2048 + k * 1024); } while (0)
#define PG8_MMA(ai, bj, At, Bt) do { __builtin_amdgcn_s_setprio(1); _Pragma("unroll") for (int m = 0; m < 4; ++m) _Pragma("unroll") for (int n = 0; n < 2; ++n) _Pragma("unroll") for (int k = 0; k < 2; ++k) \
        acc[ai][bj][m][n] = __builtin_amdgcn_mfma_f32_16x16x32_bf16(Bt[n][k], At[m][k], acc[ai][bj][m][n], 0, 0, 0); __builtin_amdgcn_s_setprio(0); } while (0)
#define PG8_WAIT_V(n) asm volatile("s_waitcnt vmcnt(" #n ")" ::: "memory")
#define PG8_WAIT_L(n) asm volatile("s_waitcnt lgkmcnt(" #n ")" ::: "memory")
#define PG8_BAR __builtin_amdgcn_s_barrier()
#define PG8_SCHED __builtin_amdgcn_sched_barrier(0)
    Unit cur, nxt; int ui = 0;
    if (!S.next(0, cur)) return;
    f32x4 acc[2][2][4][2];
#pragma unroll
    for (int a = 0; a < 2; ++a)
#pragma unroll
        for (int b = 0; b < 2; ++b)
#pragma unroll
            for (int m = 0; m < 4; ++m)
#pragma unroll
                for (int n = 0; n < 2; ++n) acc[a][b][m][n] = (f32x4){0.f, 0.f, 0.f, 0.f};
    bf16x8 At[4][2], B0[2][2], B1[2][2];
    const char* cA = (const char*)g.A + (size_t)cur.pm * tstep; const char* cB = (const char*)g.Bt + (size_t)cur.pn * tstep;
    if constexpr (HET) { cA = S.abase(cur) + (size_t)cur.pm * tstep; cB = S.bbase(cur) + (size_t)cur.pn * tstep; nt = S.nt(cur); }
    S.a_ready(cur);
    if constexpr (SP2) {
        PG8_STAGE(PG8_SB(0, 0), cB, voffB); PG8_STAGE(PG8_SB(0, 1), cB + hstep, voffB); PG8_STAGE(PG8_SA(0, 0), cA, voffA); PG8_STAGE(PG8_SA(0, 1), cA + hstep, voffA);
        if (wr == 1) PG8_BAR;
        PG8_WAIT_V(2); PG8_BAR;
        PG8_STAGE(PG8_SB(1, 0), cB + kstep, voffB); PG8_STAGE(PG8_SA(1, 0), cA + kstep, voffA); PG8_STAGE(PG8_SB(1, 1), cB + hstep + kstep, voffB);
        PG8_WAIT_V(6); PG8_BAR;
    } else {
        PG8_STAGE(PG8_SB(0, 0), cB, voffB); PG8_STAGE(PG8_SA(0, 0), cA, voffA); PG8_STAGE(PG8_SB(0, 1), cB + hstep, voffB); PG8_STAGE(PG8_SA(0, 1), cA + hstep, voffA);
        if (wr == 1) PG8_BAR;
        PG8_WAIT_V(4); PG8_BAR;
        PG8_STAGE(PG8_SB(1, 0), cB + kstep, voffB); PG8_STAGE(PG8_SA(1, 0), cA + kstep, voffA); PG8_STAGE(PG8_SB(1, 1), cB + hstep + kstep, voffB);
        PG8_WAIT_V(6); PG8_BAR;
    }
    for (;;) {
        const bool has_next = S.next(ui + 1, nxt);
        const char* nA = has_next ? (const char*)g.A + (size_t)nxt.pm * tstep : cA; const char* nB = has_next ? (const char*)g.Bt + (size_t)nxt.pn * tstep : cB;
        if constexpr (HET) { if (has_next) { nA = S.abase(nxt) + (size_t)nxt.pm * tstep; nB = S.bbase(nxt) + (size_t)nxt.pn * tstep; } }
        for (int t = 0; t < nt; t += 2) {
            const bool last = (t == nt - 2);
            const char* a1 = cA + (size_t)(t + 1) * kstep;
            const char* a2 = last ? nA : cA + (size_t)(t + 2) * kstep; const char* b2 = last ? nB : cB + (size_t)(t + 2) * kstep;
            const char* a3 = a2 + kstep; const char* b3 = b2 + kstep;
            if (last && has_next) S.a_ready(nxt);
            if constexpr (SP2) {
            PG8_LDB(B0, 0, 0); PG8_LDB(B1, 0, 1); PG8_SCHED; PG8_LDA(At, 0, 0); PG8_STAGE(PG8_SA(1, 1), a1 + hstep, voffA);
            PG8_WAIT_V(8); PG8_WAIT_L(0); PG8_BAR; PG8_MMA(0, 0, At, B0); PG8_MMA(0, 1, At, B1); PG8_BAR; PG8_SCHED;
            PG8_LDA(At, 0, 1); PG8_STAGE(PG8_SB(0, 0), b2, voffB); PG8_STAGE(PG8_SB(0, 1), b2 + hstep, voffB); PG8_STAGE(PG8_SA(0, 0), a2, voffA);
            PG8_WAIT_V(8); PG8_WAIT_L(0); PG8_BAR; PG8_MMA(1, 0, At, B0); PG8_MMA(1, 1, At, B1); PG8_BAR; PG8_SCHED;
            PG8_LDB(B0, 1, 0); PG8_LDB(B1, 1, 1); PG8_SCHED; PG8_LDA(At, 1, 0); PG8_STAGE(PG8_SA(0, 1), a2 + hstep, voffA);
            PG8_WAIT_V(8); PG8_WAIT_L(0); PG8_BAR; PG8_MMA(0, 0, At, B0); PG8_MMA(0, 1, At, B1); PG8_BAR; PG8_SCHED;
            PG8_LDA(At, 1, 1); PG8_STAGE(PG8_SB(1, 0), b3, voffB); PG8_STAGE(PG8_SB(1, 1), b3 + hstep, voffB); PG8_STAGE(PG8_SA(1, 0), a3, voffA);
            PG8_WAIT_V(8); PG8_WAIT_L(0); PG8_BAR; PG8_MMA(1, 0, At, B0); PG8_MMA(1, 1, At, B1); PG8_BAR; PG8_SCHED;
            } else {
            PG8_LDB(B0, 0, 0); PG8_SCHED; PG8_LDA(At, 0, 0); PG8_STAGE(PG8_SA(1, 1), a1 + hstep, voffA);
            PG8_WAIT_L(8); PG8_BAR; PG8_WAIT_L(0); PG8_MMA(0, 0, At, B0); PG8_BAR; PG8_SCHED;
            PG8_LDB(B1, 0, 1); PG8_STAGE(PG8_SB(0, 0), b2, voffB);
            PG8_BAR; PG8_WAIT_L(0); PG8_MMA(0, 1, At, B1); PG8_BAR;
            PG8_LDA(At, 0, 1); PG8_STAGE(PG8_SA(0, 0), a2, voffA);
            PG8_BAR; PG8_WAIT_L(0); PG8_MMA(1, 0, At, B0); PG8_BAR; PG8_SCHED;
            PG8_STAGE(PG8_SB(0, 1), b2 + hstep, voffB);
            PG8_WAIT_V(6); PG8_BAR; PG8_MMA(1, 1, At, B1); PG8_BAR;
            PG8_LDB(B0, 1, 0); PG8_SCHED; PG8_LDA(At, 1, 0); PG8_STAGE(PG8_SA(0, 1), a2 + hstep, voffA);
            PG8_WAIT_L(8); PG8_BAR; PG8_WAIT_L(0); PG8_MMA(0, 0, At, B0); PG8_BAR; PG8_SCHED;
            PG8_LDB(B1, 1, 1); PG8_STAGE(PG8_SB(1, 0), b3, voffB);
            PG8_BAR; PG8_WAIT_L(0); PG8_MMA(0, 1, At, B1); PG8_BAR;
            PG8_LDA(At, 1, 1); PG8_STAGE(PG8_SA(1, 0), a3, voffA);
            PG8_BAR; PG8_WAIT_L(0); PG8_MMA(1, 0, At, B0); PG8_BAR; PG8_SCHED;
            PG8_STAGE(PG8_SB(1, 1), b3 + hstep, voffB);
            PG8_WAIT_V(6); PG8_BAR; PG8_MMA(1, 1, At, B1); PG8_BAR;
            }
        }
        if constexpr (ALIGN_EPI) { if (wr == 0) PG8_BAR; }
        if constexpr (!Epi::AFTER_DRAIN) { E(acc, cur, wr, wc, fr, fq); S.done(cur); }
        if (!has_next) break;
        bool clr = true; if constexpr (HET) clr = S.fresh(nxt);
        if (clr)
#pragma unroll
        for (int a = 0; a < 2; ++a)
#pragma unroll
            for (int b = 0; b < 2; ++b)
#pragma unroll
                for (int m = 0; m < 4; ++m)
#pragma unroll
                    for (int n = 0; n < 2; ++n) acc[a][b][m][n] = (f32x4){0.f, 0.f, 0.f, 0.f};
        cur = nxt; cA = nA; cB = nB; ++ui;
        if constexpr (HET) nt = S.nt(cur);
        if constexpr (ALIGN_EPI) { if (wr == 1) PG8_BAR; }
    }
    PG8_WAIT_V(0);
    if constexpr (!ALIGN_EPI) { if (wr == 0) PG8_BAR; }
    PG8_BAR;
    if constexpr (Epi::AFTER_DRAIN) { E.fused(acc, cur, wr, wc, fr, fq, lds, wid, lane); S.done(cur); }
#undef PG8_SA
#undef PG8_SB
#undef PG8_STAGE
#undef PG8_LDA
#undef PG8_LDB
#undef PG8_MMA
#undef PG8_WAIT_V
#undef PG8_WAIT_L
#undef PG8_BAR
#undef PG8_SCHED
}
}
#define GAS __attribute__((address_space(1)))
#define LAS __attribute__((address_space(3)))
typedef unsigned short bf16;
typedef unsigned v4u __attribute__((ext_vector_type(4)));
typedef float f32x4 __attribute__((ext_vector_type(4)));
typedef short bf16x8 __attribute__((ext_vector_type(8)));
typedef GAS unsigned gu32;
typedef GAS unsigned long long gu64;
#define RLX_AGENT __ATOMIC_RELAXED, __HIP_MEMORY_SCOPE_AGENT
#define LDS_WAIT() asm volatile("s_waitcnt lgkmcnt(0)" ::: "memory")
#define VM_WAIT() asm volatile("s_waitcnt vmcnt(0)" ::: "memory")
__device__ __forceinline__ unsigned long long rt() { return __builtin_amdgcn_s_memrealtime(); }
__device__ __forceinline__ unsigned f2bf(float f) { unsigned u = __builtin_bit_cast(unsigned, f); return (u + 0x7fffu + ((u >> 16) & 1u)) >> 16; }
__device__ __forceinline__ unsigned pk2(float lo, float hi) { return f2bf(lo) | (f2bf(hi) << 16); }

#define XB_TMO      128
#define XB_XCNT(j)  (256  + 64 * (j))
#define XB_XSUB(j)  (1280 + 64 * (j))
#define XB_XGEN(j)  (2304 + 64 * (j))
#define XB_TOP      3328
#define XB_TOPGEN   3392
#define XCD_BAR_WORDS 3456
#define XB_SPIN_CAP (1u << 18)

__device__ __forceinline__ unsigned xb_ld(unsigned* p)              { return __hip_atomic_load(p, __ATOMIC_RELAXED, __HIP_MEMORY_SCOPE_AGENT); }
__device__ __forceinline__ unsigned xb_add(unsigned* p, unsigned v) { return __hip_atomic_fetch_add(p, v, __ATOMIC_RELAXED, __HIP_MEMORY_SCOPE_AGENT); }
__device__ __forceinline__ unsigned xb_xcc_id() { return (unsigned)__builtin_amdgcn_s_getreg((3 << 11) | 20) & 0xFu; }
#define XB_SPIN(cond, bar) do { unsigned _sp = 0; while (cond) { __builtin_amdgcn_s_sleep(1); \
    if ((++_sp & 255u) == 0u) { if (xb_ld(&(bar)[XB_TMO])) break; if (_sp > XB_SPIN_CAP) { atomicAdd(&(bar)[XB_TMO], 1u); break; } } } } while (0)

struct XcdBarrier {
    unsigned* bar; unsigned x;
    volatile LAS unsigned* st;
};

__device__ __forceinline__ XcdBarrier xcd_barrier_post(unsigned* bar, volatile LAS unsigned* st) {
    XcdBarrier b; b.bar = bar; b.x = xb_xcc_id(); b.st = st;
    if (threadIdx.x == 0) (void)xb_add(&bar[XB_XCNT(b.x)], 1u);
    return b;
}
__device__ __forceinline__ void xcd_barrier_complete(unsigned* bar, unsigned x, unsigned& nloc, unsigned& nx) {
    const unsigned G = gridDim.x * gridDim.y * gridDim.z;
    unsigned sum, cnt, mine, sp = 0u;
    for (;;) {
        sum = 0u; cnt = 0u; mine = 0u;
#pragma unroll
        for (unsigned j = 0; j < 16; ++j) { const unsigned c = xb_ld(&bar[XB_XCNT(j)]); sum += c; cnt += (c > 0u) ? 1u : 0u; mine = (j == x) ? c : mine; }
        if (sum == G) break;
        __builtin_amdgcn_s_sleep(1);
        if ((++sp & 255u) == 0u) { if (xb_ld(&bar[XB_TMO])) break; if (sp > XB_SPIN_CAP) { atomicAdd(&bar[XB_TMO], 1u); break; } }
    }
    nloc = mine > 0u ? mine : 1u; nx = cnt > 0u ? cnt : 1u;
}

__device__ __forceinline__ void xcd_barrier(const XcdBarrier& b) {
    asm volatile("s_waitcnt vmcnt(0)" ::: "memory");
    __syncthreads();
    if (threadIdx.x == 0) {
        unsigned* bar = b.bar;
        __builtin_amdgcn_s_waitcnt(0);
        unsigned nloc = b.st[0], nx = b.st[1];
        if (nloc == 0u) { xcd_barrier_complete(bar, b.x, nloc, nx); b.st[0] = nloc; b.st[1] = nx; }
        const unsigned old = xb_add(&bar[XB_XSUB(b.x)], 1u);
        const unsigned gen = old / nloc;
        if (old + 1u == (gen + 1u) * nloc) {
            __builtin_amdgcn_fence(__ATOMIC_RELEASE, "agent");
            asm volatile("s_waitcnt vmcnt(0)" ::: "memory");
            const unsigned og = xb_add(&bar[XB_TOP], 1u);
            const unsigned tg = og / nx;
            if (og + 1u == (tg + 1u) * nx) xb_add(&bar[XB_TOPGEN], 1u);
            else XB_SPIN(xb_ld(&bar[XB_TOPGEN]) == tg, bar);
            __builtin_amdgcn_fence(__ATOMIC_ACQUIRE, "agent");
            xb_add(&bar[XB_XGEN(b.x)], 1u);
            asm volatile("s_waitcnt vmcnt(0)" ::: "memory");
        } else {
            XB_SPIN(xb_ld(&bar[XB_XGEN(b.x)]) == gen, bar);
            __builtin_amdgcn_fence(__ATOMIC_ACQUIRE, "agent");
            asm volatile("s_waitcnt vmcnt(0)" ::: "memory");
        }
    }
    __syncthreads();
}
constexpr int NWAVES = 8;
constexpr int RING_BYTES = 131072;
constexpr int LDSCTL_OFF = 155648 - 512, MISC_OFF = LDSCTL_OFF + 320;
constexpr int DSA_X_OFF = 139264;
constexpr int LDS_BYTES = 155648;
static_assert(DSA_X_OFF + 8 * 1024 + 8 * 512 <= LDS_BYTES - 512, "LDS map");
constexpr int NSTEPS = NL * 13 + 1;


struct Frame {
    LAS unsigned char* lds;
    volatile LAS unsigned* MISC;
    gu32* ctl;
    int tid, lane, wave, G, bid;
    unsigned char* ws;
    size_t prow;
};
__device__ __forceinline__ float bf2f(unsigned short b) { return __uint_as_float((unsigned)b << 16); }
#define pk2(lo_, hi_) pg8::cvt_pk_bf16((lo_), (hi_))
__device__ __forceinline__ float wave_sum(float v) {
#pragma unroll
    for (int o = 32; o >= 1; o >>= 1) v += __shfl_xor(v, o);
    return v;
}
__device__ __forceinline__ float wave_max(float v) {
#pragma unroll
    for (int o = 32; o >= 1; o >>= 1) v = fmaxf(v, __shfl_xor(v, o));
    return v;
}
__device__ __forceinline__ float silu_f(float x) { return x * __builtin_amdgcn_rcpf(1.0f + __expf(-x)); }
constexpr unsigned RS = 272;
typedef short s16x4 __attribute__((ext_vector_type(4)));
typedef short v4i16_t __attribute__((ext_vector_type(4)));
#define WAVE_LDS_FENCE() do { asm volatile("s_waitcnt lgkmcnt(0)" ::: "memory"); __builtin_amdgcn_wave_barrier(); asm volatile("" ::: "memory"); } while (0)

__device__ __forceinline__ int src_in(int r) {
    if (r < 2560) return r;
    if (r < 3072) return 2576 + (r - 2560);
    if (r < 3200) return 3088 + (r - 3072);
    if (r < 3328) return 3216 + (r - 3200);
    if (r < 3584) return 3344 + (r - 3328);
    if (r < 4096) return 3668 + (r - 3584);
    if (r < 7168) return 4180 + (r - 4096);
    if (r < 7232) return 3600 + (r - 7168);
    if (r < 7248) return 2560 + (r - 7232);
    if (r < 7252) return 3664 + (r - 7248);
    return -1;
}
__device__ __forceinline__ int src_ffi(int r) { const int t = r >> 8, w = r & 255; return w < 128 ? t * 128 + w : FFH + t * 128 + (w - 128); }
template <int MODE>
__device__ __forceinline__ void cvt_item(const float* W, int ldw, int K, int Ndst, bf16* WT, LAS float* scr, int item, int tid, const float* kg) {
    const int nblk = Ndst / 256, kb = item / nblk, nb = item % nblk, k0 = 64 * kb, r0 = 256 * nb;
    const int n4 = 4 * (tid & 63), rsub = tid >> 6;
    const int sc = MODE == 1 ? src_in(r0 + n4) : MODE == 2 ? src_ffi(r0 + n4) : r0 + n4;
    f32x4 v[8];
#pragma unroll
    for (int i = 0; i < 8; ++i) v[i] = sc >= 0 ? *(const f32x4*)(W + (size_t)(k0 + 8 * i + rsub) * ldw + sc) : (f32x4){0.f, 0.f, 0.f, 0.f};
#pragma unroll
    for (int i = 0; i < 8; ++i) { const int kk = 8 * i + rsub; const float gk = kg ? kg[k0 + kk] : 1.0f; LAS float* d = scr + kk * 257 + n4; d[0] = v[i].x * gk; d[1] = v[i].y * gk; d[2] = v[i].z * gk; d[3] = v[i].w * gk; }
    __syncthreads();
#pragma unroll
    for (int j = 0; j < 4; ++j) { const int idx = tid + 512 * j, nn = idx >> 3, c = idx & 7; const LAS float* sp = scr + (8 * c) * 257 + nn;
        v4u o; o.x = pk2(sp[0 * 257], sp[1 * 257]); o.y = pk2(sp[2 * 257], sp[3 * 257]); o.z = pk2(sp[4 * 257], sp[5 * 257]); o.w = pk2(sp[6 * 257], sp[7 * 257]);
        *(GAS v4u*)(WT + (size_t)(r0 + nn) * K + k0 + 8 * c) = o; }
    __syncthreads();
}
struct LayerW { const float *w_in, *w_us, *w_ua, *w_up, *w_out, *w_fi, *w_fo, *pool_w, *pool_scale, *g_n1, *g_ssd, *g_n2; };
__device__ __forceinline__ void phase_convert(Frame& F, const LayerW& W) {
    LAS float* scr = (LAS float*)(F.lds);
    constexpr int I_IN = (D / 64) * (INW_PAD / 256), I_US = (D / 64) * (D / 256), I_UA = (512 / 64) * (D / 256), I_OUT = I_US, I_FI = (D / 64) * (2 * FFH / 256), I_FO = (FFH / 64) * (D / 256);
    constexpr int NITEMS = I_IN + I_US + I_UA + I_OUT + I_FI + I_FO;
    for (int it = F.bid; it < NITEMS; it += F.G) {
        int r = it;
        if (r < I_IN) { cvt_item<1>(W.w_in, INW, D, INW_PAD, (bf16*)(F.ws + WS_WIN), scr, r, F.tid, W.g_n1); continue; } r -= I_IN;
        if (r < I_US) { cvt_item<0>(W.w_us, D, D, D, (bf16*)(F.ws + WS_WUS), scr, r, F.tid, W.g_ssd); continue; } r -= I_US;
        if (r < I_UA) { cvt_item<0>(W.w_ua, D, 1024, D, (bf16*)(F.ws + WS_WUA), scr, r, F.tid, nullptr); continue; } r -= I_UA;
        if (r < I_OUT) { cvt_item<0>(W.w_out, D, D, D, (bf16*)(F.ws + WS_WOUT), scr, r, F.tid, nullptr); continue; } r -= I_OUT;
        if (r < I_FI) { cvt_item<2>(W.w_fi, 2 * FFH, D, 2 * FFH, (bf16*)(F.ws + WS_WFI), scr, r, F.tid, W.g_n2); continue; } r -= I_FI;
        cvt_item<0>(W.w_fo, D, FFH, D, (bf16*)(F.ws + WS_WFO), scr, r, F.tid, nullptr);
    }
    bf16* WC = (bf16*)(F.ws + WS_WUA) + 512;
    LAS float* Al = (LAS float*)(F.lds); LAS float* red = (LAS float*)(F.lds + 4096);
    for (int u = F.bid; u < 256; u += F.G) {
        const int kc0 = 4 * (u >> 1), g = kc0 >> 7, c0 = kc0 & 127, dq = F.tid >> 7, tl = F.tid & 127, n4 = (u & 1) * 512 + tl * 4;
        { const int i = F.tid >> 7, d = F.tid & 127; Al[d * 4 + i] = W.pool_w[((size_t)g * 128 + c0 + i) * 128 + d] * W.pool_scale[g * 128 + d]; }
        const float* up = W.w_up + (size_t)(g * 128 + dq * 32) * D + n4;
        f32x4 uv[32];
#pragma unroll
        for (int dd = 0; dd < 32; ++dd) uv[dd] = *(const f32x4*)(up + (size_t)dd * D);
        __syncthreads();
        f32x4 acc[4];
#pragma unroll
        for (int i = 0; i < 4; ++i) acc[i] = (f32x4){0.f, 0.f, 0.f, 0.f};
#pragma unroll
        for (int dd = 0; dd < 32; ++dd) { const f32x4 a = *(const LAS f32x4*)(Al + (dq * 32 + dd) * 4);
#pragma unroll
            for (int i = 0; i < 4; ++i) acc[i] += a[i] * uv[dd]; }
#pragma unroll
        for (int i = 0; i < 4; ++i) *(LAS f32x4*)(red + (dq * 128 + tl) * 16 + i * 4) = acc[i];
        __syncthreads();
        { const int j = F.tid >> 7; float r[4];
#pragma unroll
            for (int i = 0; i < 4; ++i) r[i] = (red[(0 * 128 + tl) * 16 + i * 4 + j] + red[(1 * 128 + tl) * 16 + i * 4 + j]) + (red[(2 * 128 + tl) * 16 + i * 4 + j] + red[(3 * 128 + tl) * 16 + i * 4 + j]);
            *(unsigned long long*)(WC + (size_t)((u & 1) * 512 + tl * 4 + j) * 1024 + kc0) = (unsigned long long)pk2(r[0], r[1]) | ((unsigned long long)pk2(r[2], r[3]) << 32); }
        __syncthreads();
    }
}
__device__ __forceinline__ void phase_prep(Frame& F, const float* __restrict__ src, bf16* __restrict__ dst, float* __restrict__ pss, int nrows) {
    const int gw = F.bid * NWAVES + F.wave, NGW = F.G * NWAVES;
    for (int m = gw; m < nrows; m += NGW) {
        const f32x4* xr = (const f32x4*)(src + (size_t)m * D) + F.lane;
        f32x4 v[4]; float s = 0.f;
#pragma unroll
        for (int j = 0; j < 4; ++j) { v[j] = xr[64 * j]; s += (v[j].x * v[j].x + v[j].y * v[j].y) + (v[j].z * v[j].z + v[j].w * v[j].w); }
        s = wave_sum(s);
        unsigned long long* o8 = (unsigned long long*)(dst + (size_t)m * D) + F.lane;
#pragma unroll
        for (int j = 0; j < 4; ++j) o8[64 * j] = (unsigned long long)pk2(v[j].x, v[j].y) | ((unsigned long long)pk2(v[j].z, v[j].w) << 32);
        if (F.lane < 4) pss[(size_t)m * 4 + F.lane] = F.lane == 0 ? s : 0.f;
    }
}
__device__ __forceinline__ void phase_final(Frame& F, const bf16* __restrict__ xn, const float* __restrict__ pss, const float* __restrict__ gain, float* __restrict__ out, int nrows) {
    const int gw = F.bid * NWAVES + F.wave, NGW = F.G * NWAVES;
    f32x4 g[4];
#pragma unroll
    for (int j = 0; j < 4; ++j) g[j] = ((const f32x4*)gain)[F.lane + 64 * j];
    for (int m = gw; m < nrows; m += NGW) {
        const float r = pg8::row_rstd(pss + (size_t)m * 4);
        const unsigned long long* x8 = (const unsigned long long*)(xn + (size_t)m * D) + F.lane;
        f32x4* o = (f32x4*)(out + (size_t)m * D) + F.lane;
#pragma unroll
        for (int j = 0; j < 4; ++j) { const unsigned long long v = x8[64 * j]; const unsigned lo = (unsigned)v, hi = (unsigned)(v >> 32);
            o[64 * j] = (f32x4){pg8::bf_lo(lo), pg8::bf_hi(lo), pg8::bf_lo(hi), pg8::bf_hi(hi)} * r * g[j]; }
    }
}
__device__ __forceinline__ void unpack8(const v4u x, float (&f)[8]) { f[0] = pg8::bf_lo(x.x); f[1] = pg8::bf_hi(x.x); f[2] = pg8::bf_lo(x.y); f[3] = pg8::bf_hi(x.y); f[4] = pg8::bf_lo(x.z); f[5] = pg8::bf_hi(x.z); f[6] = pg8::bf_lo(x.w); f[7] = pg8::bf_hi(x.w); }
__device__ __forceinline__ void phase_conv_own(Frame& F, const float* conv_w, const float* conv_b) {
    const bf16* __restrict__ XBC = (const bf16*)(F.ws + WS_XBC); bf16* __restrict__ XBCC = (bf16*)(F.ws + WS_XBCC);
    for (int u = F.bid; u < NBP * 64; u += F.G) {
        const int b_loc = u >> 6, ch = (u >> 1) & 31, g = u & 1;
        for (int it = F.tid; it < 8 * 96; it += NWAVES * 64) {
            const int blk = it / 96, cg = it % 96, c = cg < 64 ? g * 512 + cg * 8 : cg < 80 ? 1024 + g * 128 + (cg - 64) * 8 : 1280 + g * 128 + (cg - 80) * 8;
            const int t0 = ch * 128 + blk * 16, r0 = b_loc * T + t0;
            float w[4][8], bs[8];
#pragma unroll
            for (int k = 0; k < 4; ++k) { const f32x4 a = *(const f32x4*)(conv_w + k * 1536 + c), b = *(const f32x4*)(conv_w + k * 1536 + c + 4);
                w[k][0] = a.x; w[k][1] = a.y; w[k][2] = a.z; w[k][3] = a.w; w[k][4] = b.x; w[k][5] = b.y; w[k][6] = b.z; w[k][7] = b.w; }
            { const f32x4 a = *(const f32x4*)(conv_b + c), b = *(const f32x4*)(conv_b + c + 4); bs[0] = a.x; bs[1] = a.y; bs[2] = a.z; bs[3] = a.w; bs[4] = b.x; bs[5] = b.y; bs[6] = b.z; bs[7] = b.w; }
            v4u xr[19];
#pragma unroll
            for (int j = 0; j < 19; ++j) xr[j] = (j >= 3 || t0 > 0) ? *(const v4u*)(XBC + (size_t)(r0 - 3 + j) * 1536 + c) : (v4u){0u, 0u, 0u, 0u};
            float x0[8], x1[8], x2[8], x3[8];
            unpack8(xr[0], x0); unpack8(xr[1], x1); unpack8(xr[2], x2);
#pragma unroll
            for (int j = 0; j < 16; ++j) {
                unpack8(xr[j + 3], x3);
                float a[8];
#pragma unroll
                for (int i = 0; i < 8; ++i) a[i] = silu_f(bs[i] + w[0][i] * x0[i] + w[1][i] * x1[i] + w[2][i] * x2[i] + w[3][i] * x3[i]);
                v4u o; o.x = pk2(a[0], a[1]); o.y = pk2(a[2], a[3]); o.z = pk2(a[4], a[5]); o.w = pk2(a[6], a[7]);
                *(v4u*)(XBCC + (size_t)(r0 + j) * 1536 + c) = o;
#pragma unroll
                for (int i = 0; i < 8; ++i) { x0[i] = x1[i]; x1[i] = x2[i]; x2[i] = x3[i]; }
            }
        }
    }
}
template <int WIN, int NT> __device__ __forceinline__ void pool_item(const bf16* __restrict__ U, bf16* __restrict__ PO, int r0, int t0, int c) {
    v4u pre[WIN - 1], cur[NT];
#pragma unroll
    for (int i = 0; i < WIN - 1; ++i) pre[i] = (t0 - (WIN - 1) + i >= 0) ? *(const v4u*)(U + (size_t)(r0 - (WIN - 1) + i) * 512 + c) : (v4u){0u, 0u, 0u, 0u};
#pragma unroll
    for (int j = 0; j < NT; ++j) cur[j] = *(const v4u*)(U + (size_t)(r0 + j) * 512 + c);
    float s[8];
#pragma unroll
    for (int i = 0; i < 8; ++i) s[i] = 0.f;
#pragma unroll
    for (int i = 0; i < WIN - 1; ++i) { float f[8]; unpack8(pre[i], f);
#pragma unroll
        for (int k = 0; k < 8; ++k) s[k] += f[k]; }
#pragma unroll
    for (int j = 0; j < NT; ++j) {
        const int t = t0 + j, cnt = (t + 1) < WIN ? (t + 1) : WIN; const float ic = __builtin_amdgcn_rcpf((float)cnt);
        float f[8]; unpack8(cur[j], f);
#pragma unroll
        for (int k = 0; k < 8; ++k) s[k] += f[k];
        v4u o; o.x = pk2(s[0] * ic - f[0], s[1] * ic - f[1]); o.y = pk2(s[2] * ic - f[2], s[3] * ic - f[3]); o.z = pk2(s[4] * ic - f[4], s[5] * ic - f[5]); o.w = pk2(s[6] * ic - f[6], s[7] * ic - f[7]);
        *(v4u*)(PO + (size_t)(r0 + j) * 1024 + c) = o;
        float g[8]; unpack8(j - WIN + 1 >= 0 ? cur[j - WIN + 1 >= 0 ? j - WIN + 1 : 0] : pre[j < WIN - 1 ? j : 0], g);
#pragma unroll
        for (int k = 0; k < 8; ++k) s[k] -= g[k];
    }
}
__device__ __forceinline__ void phase_pool(Frame& F) {
    const bf16* __restrict__ U = (const bf16*)(F.ws + WS_U); bf16* __restrict__ PO = (bf16*)(F.ws + WS_YAP) + 512;
    if (F.wave < 4) return;
    const int grp = F.wave - 4, coct = F.lane & 15, bsub = F.lane >> 4, c = grp * 128 + coct * 8;
    for (int bq = F.bid; bq < MP / 64; bq += F.G) {
        const int blk = bq * 4 + bsub, r0 = blk * 16, t0 = r0 & (T - 1);
        if (grp == 0) pool_item<2, 16>(U, PO, r0, t0, c); else if (grp == 1) pool_item<4, 16>(U, PO, r0, t0, c); else if (grp == 2) pool_item<8, 16>(U, PO, r0, t0, c);
        else { pool_item<16, 8>(U, PO, r0, t0, c); pool_item<16, 8>(U, PO, r0 + 8, t0 + 8, c); }
    }
}
template <int CTRL> __device__ __forceinline__ int dpp0(int v) { return __builtin_amdgcn_update_dpp(0, v, CTRL, 0xf, 0xf, true); }
__device__ __forceinline__ unsigned wave_umax(unsigned v) {
    v = max(v, (unsigned)dpp0<0xB1>((int)v)); v = max(v, (unsigned)dpp0<0x4E>((int)v)); v = max(v, (unsigned)dpp0<0x141>((int)v)); v = max(v, (unsigned)dpp0<0x140>((int)v));
    return max(max((unsigned)__builtin_amdgcn_readlane((int)v, 0), (unsigned)__builtin_amdgcn_readlane((int)v, 16)), max((unsigned)__builtin_amdgcn_readlane((int)v, 32), (unsigned)__builtin_amdgcn_readlane((int)v, 48)));
}
__device__ __forceinline__ unsigned wave_umin(unsigned v) { return ~wave_umax(~v); }
__device__ __forceinline__ int wave_suffix_sum(int x, int lane) {
    int p = x; p += dpp0<0x111>(p); p += dpp0<0x112>(p); p += dpp0<0x114>(p); p += dpp0<0x118>(p);
    const int t0 = __builtin_amdgcn_readlane(p, 15), t1 = __builtin_amdgcn_readlane(p, 31), t2 = __builtin_amdgcn_readlane(p, 47), t3 = __builtin_amdgcn_readlane(p, 63);
    const int r = lane >> 4, trow = r == 0 ? t0 : r == 1 ? t1 : r == 2 ? t2 : t3, tabove = r == 0 ? t1 + t2 + t3 : r == 1 ? t2 + t3 : r == 2 ? t3 : 0;
    return trow - p + x + tabove;
}
__device__ __forceinline__ unsigned f2key(float f) { const unsigned u = __float_as_uint(f); return (u & 0x80000000u) ? ~u : (u | 0x80000000u); }
__device__ __forceinline__ int mbcnt64(unsigned long long m) { return (int)__builtin_amdgcn_mbcnt_hi((unsigned)(m >> 32), __builtin_amdgcn_mbcnt_lo((unsigned)m, 0u)); }
typedef float f32x16 __attribute__((ext_vector_type(16)));
struct DsaQ { bf16x8 aq[4]; };
__device__ __forceinline__ void dsa_load_q(Frame& F, int b_loc, int t0, DsaQ& Qn) {
    int lane_ = F.lane; asm volatile("" : "+v"(lane_)); const int lane = lane_;
    const bf16* QI = (const bf16*)(F.ws + WS_QI);
    const size_t rowb = (size_t)b_loc * T; const int r = lane & 31, hh = lane >> 5;
#pragma unroll
    for (int s = 0; s < 4; ++s) Qn.aq[s] = *(const bf16x8*)(QI + (rowb + t0 + (r >> 2)) * 256 + (r & 3) * 64 + 16 * s + 8 * hh);
}
__device__ __forceinline__ void dsa_scores(Frame& F, int b_loc, int t0, const DsaQ& Qc) {
    int lane_ = F.lane; asm volatile("" : "+v"(lane_)); const int lane = lane_;
    const size_t rowb = (size_t)b_loc * T;
    const int r = lane & 31, hh = lane >> 5;
    bf16x8 aq[4];
#pragma unroll
    for (int s = 0; s < 4; ++s) aq[s] = Qc.aq[s];
    float wq[4][4];
#pragma unroll
    for (int a = 0; a < 4; ++a) { const uint2 wr = *(const uint2*)((const bf16*)(F.ws + WS_MISC) + (F.prow + rowb + t0 + 2 * a + hh) * 256 + 80);
        wq[a][0] = pg8::bf_lo(wr.x) * 0.0625f; wq[a][1] = pg8::bf_hi(wr.x) * 0.0625f; wq[a][2] = pg8::bf_lo(wr.y) * 0.0625f; wq[a][3] = pg8::bf_hi(wr.y) * 0.0625f; }
    const int ntile = 2 * ((t0 + 8 + 63) >> 6);
    const bf16* KI = (const bf16*)(F.ws + WS_KI) + (F.prow + rowb + r) * 64 + 8 * hh;
    bf16x8 kb[4][4];
#define DSA_KBLOAD(j, tile_) do { _Pragma("unroll") for (int s = 0; s < 4; ++s) kb[j][s] = *(const bf16x8*)(KI + (size_t)(tile_) * 32 * 64 + 16 * s); } while (0)
#define DSA_TILE(j, tile_) do { const int key = (tile_) * 32 + r; f32x16 acc; _Pragma("unroll") for (int i = 0; i < 16; ++i) acc[i] = 0.f; \
        _Pragma("unroll") for (int s = 0; s < 4; ++s) acc = __builtin_amdgcn_mfma_f32_32x32x16_bf16(aq[s], kb[j][s], acc, 0, 0, 0); \
        if ((tile_) + 4 * NWAVES < ntile) DSA_KBLOAD(j, (tile_) + 4 * NWAVES); \
          \
        _Pragma("unroll") for (int a = 0; a < 4; ++a) { \
            const float sc = fmaxf(acc[4 * a + 0], 0.f) * wq[a][0] + fmaxf(acc[4 * a + 1], 0.f) * wq[a][1] + fmaxf(acc[4 * a + 2], 0.f) * wq[a][2] + fmaxf(acc[4 * a + 3], 0.f) * wq[a][3]; \
            ((LAS unsigned*)(F.lds + (2 * a + hh) * 16384))[key] = key <= t0 + 2 * a + hh ? f2key(sc) : 0u; } } while (0)
#pragma unroll
    for (int j = 0; j < 4; ++j) if ((int)F.wave + j * NWAVES < ntile) DSA_KBLOAD(j, F.wave + j * NWAVES);
    for (int tile = F.wave; tile < ntile; tile += 4 * NWAVES) {
        DSA_TILE(0, tile);
        if (tile + NWAVES < ntile) DSA_TILE(1, tile + NWAVES);
        if (tile + 2 * NWAVES < ntile) DSA_TILE(2, tile + 2 * NWAVES);
        if (tile + 3 * NWAVES < ntile) DSA_TILE(3, tile + 3 * NWAVES);
    }
#undef DSA_TILE
#undef DSA_KBLOAD
}
__device__ __forceinline__ void dsa_query(Frame& F, int b_loc, int t, bf16* YO) {
    int lane_ = F.lane; asm volatile("" : "+v"(lane_)); const int lane = lane_;
    LAS unsigned* srow = (LAS unsigned*)(F.lds + F.wave * 16384);
    LAS float* qs = (LAS float*)(F.lds + DSA_X_OFF + F.wave * 1024);
    LAS unsigned short* idxs = (LAS unsigned short*)(F.lds + DSA_X_OFF + 8 * 1024 + F.wave * 512);
    const bf16* KV = (const bf16*)(F.ws + WS_KV); const bf16* Q = (const bf16*)(F.ws + WS_Q);
    const size_t rowq = (size_t)b_loc * T + t, rowb = (size_t)b_loc * T;
    const int n = t + 1, k = n < 256 ? n : 256, nch = (n + 63) >> 6, npad = nch * 64;
#ifndef DSADUP
#define DSADUP 0
#endif
    unsigned thr = 0u; int need = 0;
    for (int rep_ = 0; rep_ <= ((DSADUP >> 1) & 1); ++rep_) {
    thr = 0u; need = 0;
    if (n > 256) {
        LAS unsigned* hist = (LAS unsigned*)qs;
        v4u kv[16];
#pragma unroll
        for (int i = 0; i < 16; ++i) { const int e = i * 256 + lane * 4; kv[i] = (v4u){0u, 0u, 0u, 0u}; if (i * 256 < npad) { if (e < npad) kv[i] = *(const LAS v4u*)(srow + e); } }
        unsigned kmn = 0xffffffffu, kmx = 0u;
#pragma unroll
        for (int i = 0; i < 16; ++i) if (i * 256 < npad) { const v4u v = kv[i];
            kmx = max(max(kmx, v.x), max(v.y, max(v.z, v.w)));
            kmn = min(min(kmn, v.x ? v.x : 0xffffffffu), min(v.y ? v.y : 0xffffffffu, min(v.z ? v.z : 0xffffffffu, v.w ? v.w : 0xffffffffu))); }
        kmx = wave_umax(kmx); kmn = wave_umin(kmn);
        unsigned lo = kmn; const unsigned range = kmx - kmn; unsigned win = range;
        int sh = range ? 32 - __builtin_clz(range) - 8 : 0; if (sh < 0) sh = 0;
        int krem = k;
        for (;;) {
            *(LAS v4u*)(hist + lane * 4) = (v4u){0u, 0u, 0u, 0u};
            WAVE_LDS_FENCE();
#pragma unroll
            for (int i = 0; i < 16; ++i) if (i * 256 < npad) { const v4u v = kv[i];
                const unsigned d0 = v.x - lo, d1 = v.y - lo, d2 = v.z - lo, d3 = v.w - lo;
                if (d0 <= win) (void)__hip_atomic_fetch_add(hist + (d0 >> sh), 1u, __ATOMIC_RELAXED, __HIP_MEMORY_SCOPE_WORKGROUP); if (d1 <= win) (void)__hip_atomic_fetch_add(hist + (d1 >> sh), 1u, __ATOMIC_RELAXED, __HIP_MEMORY_SCOPE_WORKGROUP);
                if (d2 <= win) (void)__hip_atomic_fetch_add(hist + (d2 >> sh), 1u, __ATOMIC_RELAXED, __HIP_MEMORY_SCOPE_WORKGROUP); if (d3 <= win) (void)__hip_atomic_fetch_add(hist + (d3 >> sh), 1u, __ATOMIC_RELAXED, __HIP_MEMORY_SCOPE_WORKGROUP); }
            WAVE_LDS_FENCE();
            const v4u hv = *(const LAS v4u*)(hist + lane * 4);
            const int tl = (int)(hv.x + hv.y + hv.z + hv.w); const int sfx = wave_suffix_sum(tl, lane);
            const int above = sfx - tl;
            const bool mine = above < krem && sfx >= krem;
            int bsel, babove, bcnt;
            { int c = above + (int)hv.w; if (c >= krem) { bsel = 3; babove = above; bcnt = (int)hv.w; }
              else { const int c2 = c + (int)hv.z; if (c2 >= krem) { bsel = 2; babove = c; bcnt = (int)hv.z; }
              else { const int c1 = c2 + (int)hv.y; if (c1 >= krem) { bsel = 1; babove = c2; bcnt = (int)hv.y; } else { bsel = 0; babove = c1; bcnt = (int)hv.x; } } } }
            const unsigned long long mm = __ballot(mine);
            const int src = mm ? (int)__builtin_ctzll(mm) : 0;
            const int bstar = 4 * src + __builtin_amdgcn_readlane(bsel, src), ab = __builtin_amdgcn_readlane(babove, src), cb = __builtin_amdgcn_readlane(bcnt, src);
            krem -= ab; lo += (unsigned)bstar << sh;
            if (cb == krem) { thr = lo - 1u; need = 0; break; }
            if (sh == 0) { thr = lo; need = krem; break; }
            win = (1u << sh) - 1u; sh = sh > 8 ? sh - 8 : 0;
        }
        if (need == 0) {
            int base = 0;
#pragma unroll
            for (int i = 0; i < 16; ++i) if (i * 256 < npad) { const v4u v = kv[i]; const int e = i * 256 + lane * 4;
                const bool c0 = v.x > thr, c1 = v.y > thr, c2 = v.z > thr, c3 = v.w > thr;
                const unsigned long long m0 = __ballot(c0), m1 = __ballot(c1), m2 = __ballot(c2), m3 = __ballot(c3);
                int pos = base + mbcnt64(m0) + mbcnt64(m1) + mbcnt64(m2) + mbcnt64(m3);
                if (c0) idxs[pos++] = (unsigned short)e; if (c1) idxs[pos++] = (unsigned short)(e + 1); if (c2) idxs[pos++] = (unsigned short)(e + 2); if (c3) idxs[pos] = (unsigned short)(e + 3);
                base += __builtin_popcountll(m0) + __builtin_popcountll(m1) + __builtin_popcountll(m2) + __builtin_popcountll(m3); }
        }
    }
    if (n <= 256 || need != 0) {
        int base = 0, eqseen = 0;
#pragma unroll 8
        for (int c = 0; c < nch; ++c) {
            const unsigned key = srow[c * 64 + lane]; const bool gt = key > thr, eq = key == thr;
            const unsigned long long eqm = __ballot(eq); const int eqrank = eqseen + mbcnt64(eqm);
            const bool inc = gt || (eq && eqrank < need);
            const unsigned long long im = __ballot(inc); const int pos = base + mbcnt64(im);
            if (inc) idxs[pos] = (unsigned short)(c * 64 + lane);
            base += __builtin_popcountll(im); eqseen += __builtin_popcountll(eqm);
        }
    }
    WAVE_LDS_FENCE();
    }
    for (int rep_ = ((DSADUP >> 2) & 1); rep_ >= 0; --rep_)
    {
        const int hc = lane & 15, g = lane >> 4;
        const bf16* Qr = Q + rowq * 512 + hc * 64 + 8 * g;
        const bf16x8 zf = (bf16x8){0, 0, 0, 0, 0, 0, 0, 0};
        bf16x8 bq[4];
        bq[0] = hc < 4 ? *(const bf16x8*)(Qr) : zf; bq[1] = hc < 4 ? *(const bf16x8*)(Qr + 32) : zf;
        bq[2] = (hc >= 4 && hc < 8) ? *(const bf16x8*)(Qr) : zf; bq[3] = (hc >= 4 && hc < 8) ? *(const bf16x8*)(Qr + 32) : zf;
        v4u il[8];
#pragma unroll
        for (int i = 0; i < 8; ++i) il[i] = *(const LAS v4u*)(idxs + 64 * g + 8 * i);
#define DSA_IDX(m) ((int)((((m) & 7) < 2 ? il[(m) >> 3].x : ((m) & 7) < 4 ? il[(m) >> 3].y : ((m) & 7) < 6 ? il[(m) >> 3].z : il[(m) >> 3].w) >> (16 * ((m) & 1))) & 0xffff)
        LAS unsigned char* ring = (LAS unsigned char*)srow;
#define DSA_DMA(gp, lp) __builtin_amdgcn_global_load_lds((const unsigned*)(gp), (LAS unsigned*)(lp), 16, 0, 0)
#define DSA_VMWAIT(n) asm volatile("s_waitcnt vmcnt(" #n ")" ::: "memory")
#define DSA_KISSUE(tl) do { _Pragma("unroll") for (int i = 0; i < 4; ++i) { const int ridx = 64 * g + 4 * (tl) + i < k ? DSA_IDX(4 * (tl) + i) : 0; \
            DSA_DMA(KV + (rowb + ridx) * 256 + 8 * (hc ^ (2 * ((4 * i + g) & 7))), ring + ((tl) & 3) * 4096 + i * 1024); } } while (0)
        f32x4 sc[16];
        DSA_KISSUE(0); DSA_KISSUE(1); DSA_KISSUE(2); DSA_KISSUE(3);
#pragma unroll
        for (int tl = 0; tl < 16; ++tl) {
            if (tl <= 12) DSA_VMWAIT(12); else if (tl == 13) DSA_VMWAIT(8); else if (tl == 14) DSA_VMWAIT(4); else DSA_VMWAIT(0);
            const LAS unsigned char* kt = ring + (tl & 3) * 4096 + hc * 256;
            bf16x8 ka[4];
#pragma unroll
            for (int ks = 0; ks < 4; ++ks) ka[ks] = *(const LAS bf16x8*)(kt + 16 * ((4 * ks + g) ^ (2 * (hc & 7))));
            f32x4 a = (f32x4){0.f, 0.f, 0.f, 0.f};
#pragma unroll
            for (int ks = 0; ks < 4; ++ks) a = __builtin_amdgcn_mfma_f32_16x16x32_bf16(ka[ks], bq[ks], a, 0, 0, 0);
            sc[tl] = a;
            asm volatile("s_waitcnt lgkmcnt(0)" ::: "memory");
            if (tl + 4 < 16) DSA_KISSUE(tl + 4);
        }
#undef DSA_KISSUE
#define DSA_VISSUE(c) do { _Pragma("unroll") for (int i = 0; i < 8; ++i) { const int ridx = 64 * g + 8 * (c) + i < k ? DSA_IDX(8 * (c) + i) : 0; \
            DSA_DMA(KV + (rowb + ridx) * 256 + 128 + 8 * (hc ^ (2 * ((4 * i + g) & 7))), ring + ((c) & 1) * 8192 + i * 1024); } } while (0)
        DSA_VISSUE(0); DSA_VISSUE(1);
        float mx = -INFINITY;
#pragma unroll
        for (int tl = 0; tl < 16; ++tl)
#pragma unroll
            for (int e = 0; e < 4; ++e) { const float v = (64 * e + 4 * tl + g) < k ? sc[tl][e] * 0.125f : -INFINITY; sc[tl][e] = v; mx = fmaxf(mx, v); }
        mx = fmaxf(mx, __shfl_xor(mx, 16)); mx = fmaxf(mx, __shfl_xor(mx, 32));
        float sum = 0.f;
#pragma unroll
        for (int tl = 0; tl < 16; ++tl)
#pragma unroll
            for (int e = 0; e < 4; ++e) { const float p = __expf(sc[tl][e] - mx); sc[tl][e] = p; sum += p; }
        sum += __shfl_xor(sum, 16); sum += __shfl_xor(sum, 32);
        const float inv = 1.0f / sum;
        bf16x8 pb[8];
#pragma unroll
        for (int c = 0; c < 8; ++c) { const unsigned p0 = pk2(sc[2 * c][0], sc[2 * c][1]), p1 = pk2(sc[2 * c][2], sc[2 * c][3]), p2 = pk2(sc[2 * c + 1][0], sc[2 * c + 1][1]), p3 = pk2(sc[2 * c + 1][2], sc[2 * c + 1][3]);
            pb[c][0] = (short)(p0 & 0xffff); pb[c][1] = (short)(p0 >> 16); pb[c][2] = (short)(p1 & 0xffff); pb[c][3] = (short)(p1 >> 16);
            pb[c][4] = (short)(p2 & 0xffff); pb[c][5] = (short)(p2 >> 16); pb[c][6] = (short)(p3 & 0xffff); pb[c][7] = (short)(p3 >> 16); }
        f32x4 o[8];
#pragma unroll
        for (int mt = 0; mt < 8; ++mt) o[mt] = (f32x4){0.f, 0.f, 0.f, 0.f};
        const unsigned q4 = (lane & 15) >> 2, p4 = lane & 3;
#pragma unroll
        for (int c = 0; c < 8; ++c) {
            if (c < 7) DSA_VMWAIT(8); else DSA_VMWAIT(0);
            const LAS unsigned char* Vimg = ring + (c & 1) * 8192;
#pragma unroll
            for (int mt = 0; mt < 8; ++mt) {
                const unsigned vo = 16 * ((2 * mt + (p4 >> 1)) ^ (2 * ((4 * g + q4) & 7))) + 8 * (p4 & 1);
                const s16x4 lo4 = __builtin_amdgcn_ds_read_tr16_b64_v4i16((LAS v4i16_t*)(Vimg + (4 * g + q4) * 256 + vo));
                const s16x4 hi4 = __builtin_amdgcn_ds_read_tr16_b64_v4i16((LAS v4i16_t*)(Vimg + (16 + 4 * g + q4) * 256 + vo));
                const bf16x8 va = (bf16x8){lo4.x, lo4.y, lo4.z, lo4.w, hi4.x, hi4.y, hi4.z, hi4.w};
                o[mt] = __builtin_amdgcn_mfma_f32_16x16x32_bf16(va, pb[c], o[mt], 0, 0, 0);
            }
            asm volatile("s_waitcnt lgkmcnt(0)" ::: "memory");
            if (c + 2 < 8) DSA_VISSUE(c + 2);
        }
#undef DSA_VISSUE
#undef DSA_VMWAIT
#undef DSA_DMA
#undef DSA_IDX
        if (hc < 8) {
            bf16* op = (rep_ ? (bf16*)(F.ws + WS_STATES) : YO) + rowq * 1024 + hc * 64 + 4 * g;
#pragma unroll
            for (int mt = 0; mt < 4; ++mt) { const f32x4 v = (hc < 4 ? o[mt] : o[4 + mt]) * inv;
                *(unsigned long long*)(op + 16 * mt) = (unsigned long long)pk2(v[0], v[1]) | ((unsigned long long)pk2(v[2], v[3]) << 32); }
        }
    }
}
__device__ __forceinline__ void dsa_unit(Frame& F, int i, int& b_loc, int& qb) {
    const long u = (long)F.bid + (long)F.G * i; const int r = (int)(u % 512);
    b_loc = (int)(u / 512);
    const int pi = (r & 255), pm = (b_loc & 1) ? 255 - pi : pi;
    qb = r < 256 ? pm : 511 - pm;
}
__device__ __forceinline__ void phase_dsa(Frame& F, bf16* YO) {
    const int nu = (int)(((long)NBP * 512 - F.bid + F.G - 1) / F.G);
    for (int i = 0; i < nu; ++i) {
        int b_loc, qb; dsa_unit(F, i, b_loc, qb);
        __syncthreads();
        for (int rep_ = 0; rep_ <= (DSADUP & 1); ++rep_) { DsaQ Qc; dsa_load_q(F, b_loc, qb * 8, Qc); dsa_scores(F, b_loc, qb * 8, Qc); }
        __syncthreads();
        dsa_query(F, b_loc, qb * 8 + F.wave, YO);
    }
}
__device__ __forceinline__ unsigned rr16(unsigned lane, unsigned rb, unsigned s) { return ((lane & 15) + 16 * rb) * RS + 64 * s + 16 * (lane >> 4); }
__device__ __forceinline__ unsigned tr16(unsigned lane, unsigned c, unsigned ks, unsigned t) { const unsigned g = lane >> 4, q = (lane & 15) >> 2, p = lane & 3; return (32 * ks + 8 * g + 4 * t + q) * RS + (16 * c + 4 * p) * 2; }
__device__ __forceinline__ bf16x8 rowfrag(LAS unsigned char* img, unsigned lane, unsigned rb, unsigned s) { return *(const LAS bf16x8*)(img + rr16(lane, rb, s)); }
__device__ __forceinline__ bf16x8 trfrag(LAS unsigned char* img, unsigned lane, unsigned c, unsigned ks) {
    const s16x4 lo = __builtin_amdgcn_ds_read_tr16_b64_v4i16((LAS v4i16_t*)(img + tr16(lane, c, ks, 0))), hi = __builtin_amdgcn_ds_read_tr16_b64_v4i16((LAS v4i16_t*)(img + tr16(lane, c, ks, 1)));
    return (bf16x8){lo.x, lo.y, lo.z, lo.w, hi.x, hi.y, hi.z, hi.w};
}
__device__ __forceinline__ float softplus_f(float x) { return x > 20.f ? x : log1pf(__expf(x)); }
__device__ __forceinline__ float ssd_tables(const bf16* MS, size_t row0, int h, float bias, float A, LAS float* acs, LAS float* dts, int lane) {
    const float dt0 = softplus_f(bf2f(MS[(row0 + 2 * lane) * 256 + 64 + h]) + bias), dt1 = softplus_f(bf2f(MS[(row0 + 2 * lane + 1) * 256 + 64 + h]) + bias);
    const float a0 = dt0 * A, a1 = dt1 * A; float s = a0 + a1;
#pragma unroll
    for (int o = 1; o < 64; o <<= 1) { const float t = __shfl_up(s, o); if (lane >= o) s += t; }
    const float ex = s - (a0 + a1);
    acs[2 * lane] = ex + a0; acs[2 * lane + 1] = ex + a0 + a1; dts[2 * lane] = dt0; dts[2 * lane + 1] = dt1;
    return __shfl(s, 63);
}
__device__ __forceinline__ void phase_ssd_states(Frame& F, const float* dt_bias, const float* a_log) {
    const bf16* XC = (const bf16*)(F.ws + WS_XBCC); const bf16* MS = (const bf16*)(F.ws + WS_MISC) + F.prow * 256; bf16* ST = (bf16*)(F.ws + WS_STATES); float* DEC = (float*)(F.ws + WS_DEC);
    const int tid = F.tid, lane = F.lane, w = F.wave;
    LAS unsigned char* Bs = F.lds;
    LAS unsigned char* Xi = F.lds + 128 * RS + (w >> 2) * (128 * RS);
    LAS float* acs = (LAS float*)(F.lds + DSA_X_OFF + w * 1024); LAS float* dts = acs + 128;
    for (int u = F.bid; u < NBP * 64; u += F.G) {
        const int b_loc = u >> 6, c = (u >> 1) & 31, g = u & 1, h = g * 8 + w;
        const size_t row0 = (size_t)b_loc * T + c * 128;
        const float A = -__expf(a_log[h]);
        __syncthreads();
        const float a_end = ssd_tables(MS, row0, h, dt_bias[h], A, acs, dts, lane);
#pragma unroll
        for (int i = 0; i < 4; ++i) { const int idx = tid + 512 * i, r = idx >> 4, ch = idx & 15;
            const v4u v = __builtin_nontemporal_load((const v4u*)(XC + (row0 + r) * 1536 + 1024 + g * 128 + ch * 8)); *(LAS v4u*)(Bs + r * RS + 16 * (ch)) = v; }
        asm volatile("s_waitcnt lgkmcnt(0)" ::: "memory"); __builtin_amdgcn_wave_barrier();
        bf16* sp = ST + ((size_t)((b_loc * 32 + c) * 16 + h)) * 8192;
        for (int ph = 0; ph < 2; ++ph) {
            if (ph) __syncthreads();
#pragma unroll
            for (int i = 0; i < 8; ++i) { const int idx = lane + 64 * i, r = idx >> 2, c4 = idx & 3;
                const v4u v = __builtin_nontemporal_load((const v4u*)(XC + (row0 + r) * 1536 + h * 64 + 32 * ph + c4 * 8));
                const float sc = dts[r] * __expf(a_end - acs[r]);
                v4u o; o.x = pk2(pg8::bf_lo(v.x) * sc, pg8::bf_hi(v.x) * sc); o.y = pk2(pg8::bf_lo(v.y) * sc, pg8::bf_hi(v.y) * sc); o.z = pk2(pg8::bf_lo(v.z) * sc, pg8::bf_hi(v.z) * sc); o.w = pk2(pg8::bf_lo(v.w) * sc, pg8::bf_hi(v.w) * sc);
                *(LAS v4u*)(Xi + r * RS + 16 * ((w & 3) * 4 + c4)) = o; }
            __syncthreads();
            f32x4 acc[8][2];
#pragma unroll
            for (int i = 0; i < 8; ++i) { acc[i][0] = (f32x4){0.f, 0.f, 0.f, 0.f}; acc[i][1] = (f32x4){0.f, 0.f, 0.f, 0.f}; }
#pragma unroll
            for (int ks = 0; ks < 4; ++ks) {
                const bf16x8 xb0 = trfrag(Xi, lane, (w & 3) * 2 + 0, ks), xb1 = trfrag(Xi, lane, (w & 3) * 2 + 1, ks);
#pragma unroll
                for (int i = 0; i < 8; ++i) { const bf16x8 a = trfrag(Bs, lane, i, ks);
                    acc[i][0] = __builtin_amdgcn_mfma_f32_16x16x32_bf16(a, xb0, acc[i][0], 0, 0, 0); acc[i][1] = __builtin_amdgcn_mfma_f32_16x16x32_bf16(a, xb1, acc[i][1], 0, 0, 0); }
            }
#pragma unroll
            for (int i = 0; i < 8; ++i)
#pragma unroll
                for (int j = 0; j < 2; ++j) { const int pp = 32 * ph + 16 * j + (lane & 15), n = 16 * i + 4 * (lane >> 4);
                    *(unsigned long long*)(sp + pp * 128 + n) = (unsigned long long)pk2(acc[i][j][0], acc[i][j][1]) | ((unsigned long long)pk2(acc[i][j][2], acc[i][j][3]) << 32); }
        }
        if (lane == 0) DEC[(b_loc * 32 + c) * 16 + h] = __expf(a_end);
    }
}
__device__ __forceinline__ void phase_ssd_scan(Frame& F) {
    bf16* ST = (bf16*)(F.ws + WS_STATES); const float* DEC = (const float*)(F.ws + WS_DEC);
    for (int gt = F.bid * (NWAVES * 64) + F.tid; gt < NBP * 16 * 2048; gt += F.G * NWAVES * 64) {
        const int bh = gt >> 11, e4 = gt & 2047, b_loc = bh >> 4, h = bh & 15;
        bf16* sp = ST + ((size_t)(b_loc * 32) * 16 + h) * 8192 + e4 * 4; const float* dp = DEC + (b_loc * 32) * 16 + h;
        float s0 = 0.f, s1 = 0.f, s2 = 0.f, s3 = 0.f;
#pragma unroll 8
        for (int c = 0; c < 32; ++c) {
            unsigned long long* q = (unsigned long long*)(sp + (size_t)c * 16 * 8192);
            const unsigned long long v = *q; const float d = dp[c * 16];
            *q = (unsigned long long)pk2(s0, s1) | ((unsigned long long)pk2(s2, s3) << 32);
            const unsigned lo = (unsigned)v, hi = (unsigned)(v >> 32);
            s0 = s0 * d + pg8::bf_lo(lo); s1 = s1 * d + pg8::bf_hi(lo); s2 = s2 * d + pg8::bf_lo(hi); s3 = s3 * d + pg8::bf_hi(hi);
        }
    }
}
__device__ __forceinline__ void phase_ssd_out(Frame& F, const float* dt_bias, const float* a_log, const float* d_skip, bf16* ZO) {
    const bf16* XC = (const bf16*)(F.ws + WS_XBCC); const bf16* MS = (const bf16*)(F.ws + WS_MISC) + F.prow * 256; const bf16* ST = (const bf16*)(F.ws + WS_STATES); const bf16* Z = (const bf16*)(F.ws + WS_Z); float* SSQ = (float*)(F.ws + WS_SSQ);
    const int tid = F.tid, lane = F.lane, w = F.wave;
    LAS unsigned char* Cs = F.lds;
    LAS unsigned char* Bs = F.lds + 128 * RS;
    LAS unsigned char* Xi = F.lds + 256 * RS + (w >> 1) * (64 * RS);
    static_assert(256 * RS + 4 * 64 * RS <= DSA_X_OFF, "SSD LDS map");
    LAS float* acs = (LAS float*)(F.lds + DSA_X_OFF + w * 1024); LAS float* dts = acs + 128;
    LAS float* sqp = (LAS float*)(F.lds + DSA_X_OFF + 8192);
    for (int u = F.bid; u < NBP * 64; u += F.G) {
        const int b_loc = u >> 6, c = (u >> 1) & 31, g = u & 1, h = g * 8 + w;
        const size_t row0 = (size_t)b_loc * T + c * 128;
        const float A = -__expf(a_log[h]), Dh = d_skip[h];
        __syncthreads();
        (void)ssd_tables(MS, row0, h, dt_bias[h], A, acs, dts, lane);
#pragma unroll
        for (int i = 0; i < 4; ++i) { const int idx = tid + 512 * i, r = idx >> 4, ch = idx & 15; const bf16* rp = XC + (row0 + r) * 1536 + g * 128 + ch * 8;
            const v4u vb = *(const v4u*)(rp + 1024), vc = *(const v4u*)(rp + 1280); *(LAS v4u*)(Bs + r * RS + 16 * (ch)) = vb; *(LAS v4u*)(Cs + r * RS + 16 * (ch)) = vc; }
        asm volatile("s_waitcnt lgkmcnt(0)" ::: "memory"); __builtin_amdgcn_wave_barrier();
#pragma unroll
        for (int i = 0; i < 8; ++i) { const int idx = lane + 64 * i, r = idx >> 3, c8 = idx & 7;
            const v4u v = *(const v4u*)(XC + (row0 + r) * 1536 + h * 64 + c8 * 8); const float sc = dts[r];
            v4u o; o.x = pk2(pg8::bf_lo(v.x) * sc, pg8::bf_hi(v.x) * sc); o.y = pk2(pg8::bf_lo(v.y) * sc, pg8::bf_hi(v.y) * sc); o.z = pk2(pg8::bf_lo(v.z) * sc, pg8::bf_hi(v.z) * sc); o.w = pk2(pg8::bf_lo(v.w) * sc, pg8::bf_hi(v.w) * sc);
            *(LAS v4u*)(Xi + r * RS + 16 * ((w & 1) * 8 + c8)) = o; }
        __syncthreads();
        {
            f32x4 cb[8];
#pragma unroll
            for (int i = 0; i < 8; ++i) cb[i] = (f32x4){0.f, 0.f, 0.f, 0.f};
#pragma unroll
            for (int ks = 0; ks < 4; ++ks) { const bf16x8 a = rowfrag(Bs, lane, w, ks);
#pragma unroll
                for (int i = 0; i < 8; ++i) if (i >= w) cb[i] = __builtin_amdgcn_mfma_f32_16x16x32_bf16(a, rowfrag(Cs, lane, i, ks), cb[i], 0, 0, 0); }
            __syncthreads();
#pragma unroll
            for (int i = 0; i < 8; ++i) if (i >= w) { const unsigned l = 16 * i + (lane & 15);
                *(LAS unsigned long long*)(Bs + l * RS + (16 * w + 4 * (lane >> 4)) * 2) = (unsigned long long)pk2(cb[i][0], cb[i][1]) | ((unsigned long long)pk2(cb[i][2], cb[i][3]) << 32); }
            __syncthreads();
        }
        LAS unsigned char* CB = Bs;
        const bf16* pv = ST + ((size_t)((b_loc * 32 + c) * 16 + h)) * 8192 + (lane & 15) * 128 + 8 * (lane >> 4);
        for (int hl = 0; hl < 2; ++hl) {
            f32x4 acc[4][4];
#pragma unroll
            for (int j = 0; j < 4; ++j)
#pragma unroll
                for (int ii = 0; ii < 4; ++ii) acc[j][ii] = (f32x4){0.f, 0.f, 0.f, 0.f};
#pragma unroll 1
            for (int ks = 0; ks < 4; ++ks) {
                bf16x8 pa[4];
#pragma unroll
                for (int j = 0; j < 4; ++j) pa[j] = *(const bf16x8*)(pv + j * 16 * 128 + 32 * ks);
#pragma unroll
                for (int ii = 0; ii < 4; ++ii) { const bf16x8 cf = rowfrag(Cs, lane, 4 * hl + ii, ks);
#pragma unroll
                    for (int j = 0; j < 4; ++j) acc[j][ii] = __builtin_amdgcn_mfma_f32_16x16x32_bf16(pa[j], cf, acc[j][ii], 0, 0, 0); }
            }
#pragma unroll
            for (int ii = 0; ii < 4; ++ii) { const float el = __expf(acs[16 * (4 * hl + ii) + (lane & 15)]);
#pragma unroll
                for (int j = 0; j < 4; ++j) acc[j][ii] = acc[j][ii] * el; }
#pragma unroll 1
            for (int ks = 0; ks < 2 + 2 * hl; ++ks) {
                {
                    if (ks == 2) {
                        __syncthreads();
#pragma unroll
                        for (int i = 0; i < 8; ++i) { const int idx = lane + 64 * i, r = idx >> 3, c8 = idx & 7;
                            const v4u v = *(const v4u*)(XC + (row0 + 64 + r) * 1536 + h * 64 + c8 * 8); const float sc = dts[64 + r];
                            v4u o; o.x = pk2(pg8::bf_lo(v.x) * sc, pg8::bf_hi(v.x) * sc); o.y = pk2(pg8::bf_lo(v.y) * sc, pg8::bf_hi(v.y) * sc); o.z = pk2(pg8::bf_lo(v.z) * sc, pg8::bf_hi(v.z) * sc); o.w = pk2(pg8::bf_lo(v.w) * sc, pg8::bf_hi(v.w) * sc);
                            *(LAS v4u*)(Xi + r * RS + 16 * ((w & 1) * 8 + c8)) = o; }
                        __syncthreads();
                    }
                    bf16x8 xa[4];
#pragma unroll
                    for (int j = 0; j < 4; ++j) xa[j] = trfrag(Xi, lane, (w & 1) * 4 + j, ks & 1);
                    const int s0 = 32 * ks + 8 * (lane >> 4);
                    const f32x4 as0 = *(const LAS f32x4*)(acs + s0), as1 = *(const LAS f32x4*)(acs + s0 + 4);
#pragma unroll
                    for (int ii = 0; ii < 4; ++ii) if (4 * hl + ii >= 2 * ks) {
                        const int l = 16 * (4 * hl + ii) + (lane & 15);
                        const bf16x8 cbv = rowfrag(CB, lane, 4 * hl + ii, ks);
                        const float al = acs[l], dd = Dh * __builtin_amdgcn_rcpf(dts[l]);
                        float m[8];
                        m[0] = bf2f((unsigned short)cbv[0]) * __expf(al - as0.x); m[1] = bf2f((unsigned short)cbv[1]) * __expf(al - as0.y); m[2] = bf2f((unsigned short)cbv[2]) * __expf(al - as0.z); m[3] = bf2f((unsigned short)cbv[3]) * __expf(al - as0.w);
                        m[4] = bf2f((unsigned short)cbv[4]) * __expf(al - as1.x); m[5] = bf2f((unsigned short)cbv[5]) * __expf(al - as1.y); m[6] = bf2f((unsigned short)cbv[6]) * __expf(al - as1.z); m[7] = bf2f((unsigned short)cbv[7]) * __expf(al - as1.w);
#pragma unroll
                        for (int jj = 0; jj < 8; ++jj) { const int sx = s0 + jj; m[jj] = sx < l ? m[jj] : (sx == l ? m[jj] + dd : 0.f); }
                        bf16x8 mf; { const unsigned p0 = pk2(m[0], m[1]), p1 = pk2(m[2], m[3]), p2 = pk2(m[4], m[5]), p3 = pk2(m[6], m[7]);
                            mf[0] = (short)(p0 & 0xffff); mf[1] = (short)(p0 >> 16); mf[2] = (short)(p1 & 0xffff); mf[3] = (short)(p1 >> 16); mf[4] = (short)(p2 & 0xffff); mf[5] = (short)(p2 >> 16); mf[6] = (short)(p3 & 0xffff); mf[7] = (short)(p3 >> 16); }
#pragma unroll
                        for (int j = 0; j < 4; ++j) acc[j][ii] = __builtin_amdgcn_mfma_f32_16x16x32_bf16(xa[j], mf, acc[j][ii], 0, 0, 0);
                    }
                }
            }
            unsigned long long zq[4][4];
#pragma unroll
            for (int ii = 0; ii < 4; ++ii)
#pragma unroll
                for (int j = 0; j < 4; ++j) zq[ii][j] = *(const unsigned long long*)(Z + (row0 + 16 * (4 * hl + ii) + (lane & 15)) * 1024 + h * 64 + 16 * j + 4 * (lane >> 4));
#pragma unroll
            for (int ii = 0; ii < 4; ++ii) { float q = 0.f;
#pragma unroll
                for (int j = 0; j < 4; ++j) { const size_t zi = (row0 + 16 * (4 * hl + ii) + (lane & 15)) * 1024 + h * 64 + 16 * j + 4 * (lane >> 4);
                    const unsigned long long zv = zq[ii][j]; const unsigned zl = (unsigned)zv, zh = (unsigned)(zv >> 32);
                    const float g0 = acc[j][ii][0] * silu_f(pg8::bf_lo(zl)), g1 = acc[j][ii][1] * silu_f(pg8::bf_hi(zl)), g2 = acc[j][ii][2] * silu_f(pg8::bf_lo(zh)), g3 = acc[j][ii][3] * silu_f(pg8::bf_hi(zh));
                    q += (g0 * g0 + g1 * g1) + (g2 * g2 + g3 * g3);
                    *(unsigned long long*)(ZO + zi) = (unsigned long long)pk2(g0, g1) | ((unsigned long long)pk2(g2, g3) << 32); }
                q += __shfl_xor(q, 16); q += __shfl_xor(q, 32);
                if (lane < 16) sqp[(16 * (4 * hl + ii) + lane) * 8 + w] = q; }
        }
        __syncthreads();
        if (tid < 128) { const f32x4 q0 = *(const LAS f32x4*)(sqp + tid * 8), q1 = *(const LAS f32x4*)(sqp + tid * 8 + 4); SSQ[(row0 + tid) * 2 + g] = ((q0.x + q0.y) + (q0.z + q0.w)) + ((q1.x + q1.y) + (q1.z + q1.w)); }
    }
}
struct Args { const float* in[19]; float* out; unsigned char* ws; int lo, hi; };
static_assert(sizeof(Args) == 21 * 8 + 8, "Args has no holes");
#define CAS __attribute__((address_space(4)))
struct ProjOrder {
    pg8::StaticOrder S; int extra;
    __device__ __forceinline__ void init(int G, int c, int extra_) { S.init(MP, 28 * 256, G, c); extra = extra_; }
    __device__ __forceinline__ bool next(int i, pg8::Unit& u) const {
        const long Lx = (long)i * S.G + S.c;
        if (Lx < S.nwg) return S.next(i, u);
        if (Lx >= S.nwg + extra) return false;
        u.pm = (int)(Lx - S.nwg); u.pn = 28; return true;
    }
    __device__ __forceinline__ void a_ready(const pg8::Unit&) const {}
    __device__ __forceinline__ void done(const pg8::Unit&) const {}
};
struct MergeOrder {
    pg8::StaticOrder S; const char *A0, *A1, *B0, *B1;
    __device__ __forceinline__ bool next(int i, pg8::Unit& u) const { if (!S.next(i / 3, u)) return false; u.br = i % 3; return true; }
    __device__ __forceinline__ int nt(const pg8::Unit& u) const { return u.br == 0 ? 16 : 8; }
    __device__ __forceinline__ const char* abase(const pg8::Unit& u) const { return u.br == 0 ? A0 : A1 + (u.br - 1) * 1024; }
    __device__ __forceinline__ const char* bbase(const pg8::Unit& u) const { return u.br == 0 ? B0 : B1 + (u.br - 1) * 1024; }
    __device__ __forceinline__ bool fresh(const pg8::Unit& u) const { return u.br == 0; }
    __device__ __forceinline__ void a_ready(const pg8::Unit&) const {}
    __device__ __forceinline__ void done(const pg8::Unit&) const {}
};
template <class Sched> __device__ __forceinline__ pg8::RstdTab make_rstd_tab(const Sched& S, const float* pss, LAS unsigned char* lds, int tid) {
    LAS float* tab = (LAS float*)(lds + DSA_X_OFF + 4096);
    int pmA = -1, pmB = -1; pg8::Unit u;
    for (int i = 0; S.next(i, u); ++i) { if (pmA < 0) pmA = u.pm; else if (u.pm != pmA && pmB < 0) pmB = u.pm; }
    const int pmT = tid < 256 ? pmA : pmB;
    if (pmT >= 0) tab[tid] = pg8::row_rstd(pss + (size_t)(pmT * 256 + (tid & 255)) * 4);
    __syncthreads();
    return pg8::RstdTab{tab, pmA, pmB, pss};
}
__device__ __forceinline__ const CAS Args* kargs() { const CAS Args* p = (const CAS Args*)__builtin_amdgcn_kernarg_segment_ptr(); asm volatile("" : "+s"(p)); return p; }
__device__ __forceinline__ Frame mkframe(const CAS Args* A, LAS unsigned char* lds) {
    Frame F; F.lds = lds; F.MISC = (volatile LAS unsigned*)(lds + MISC_OFF);
    int t_ = threadIdx.x; asm volatile("" : "+v"(t_));
    F.tid = t_; F.lane = t_ & 63; F.wave = __builtin_amdgcn_readfirstlane(t_ >> 6);
    F.G = gridDim.x; F.bid = blockIdx.x; F.ws = A->ws; F.ctl = (gu32*)(F.ws + WS_CTL); F.prow = 0;
    return F;
}
__global__ void __launch_bounds__(NWAVES * 64, 2) trunk_fwd(Args args) {
    extern __shared__ __attribute__((aligned(16))) unsigned char lds[];
    LAS unsigned char* const L = (LAS unsigned char*)lds;
    for (int u = threadIdx.x; u < (LDS_BYTES - LDSCTL_OFF) / 4; u += NWAVES * 64) ((LAS unsigned*)(L + LDSCTL_OFF))[u] = 0u;
    __syncthreads();
    { const CAS Args* A = kargs(); (void)xcd_barrier_post((unsigned*)(A->ws + WS_CTL) + 4096, (volatile LAS unsigned*)(L + MISC_OFF) + 8); }
    const int lo = args.lo, hi = args.hi;
#ifndef PHASE_MASK
#define PHASE_MASK 0x7ff
#endif
#define PH(k) (((PHASE_MASK) >> (k)) & 1)
#ifndef DUP_MASK
#define DUP_MASK 0
#endif
#define DUP(k) (((DUP_MASK) >> (k)) & 1)
#define RUN(s) (lo <= (s) && (s) < hi)
#define SEAM_ALWAYS() do { const CAS Args* A_ = kargs(); XcdBarrier bar_; bar_.bar = (unsigned*)(A_->ws + WS_CTL) + 4096; bar_.x = xb_xcc_id(); bar_.st = (volatile LAS unsigned*)(L + MISC_OFF) + 8; xcd_barrier(bar_); if (DUP(12)) xcd_barrier(bar_); } while (0)
#define SEAM(s) do { if (RUN(s) && RUN((s) + 1)) { const CAS Args* A_ = kargs(); XcdBarrier bar_; bar_.bar = (unsigned*)(A_->ws + WS_CTL) + 4096; bar_.x = xb_xcc_id(); bar_.st = (volatile LAS unsigned*)(L + MISC_OFF) + 8; xcd_barrier(bar_); if (DUP(12)) xcd_barrier(bar_); } } while (0)
    for (int l = 0; l < NL; ++l) {
        const int sb = l * 13;
        if (PH(0) && RUN(sb)) {
            const CAS Args* A = kargs(); Frame F = mkframe(A, L);
            LayerW W; W.w_in = A->in[2] + (size_t)l * D * INW; W.w_us = A->in[11] + (size_t)l * D * D; W.w_ua = A->in[12] + (size_t)l * 512 * D; W.w_up = A->in[13] + (size_t)l * 512 * D;
            W.w_out = A->in[14] + (size_t)l * D * D; W.w_fi = A->in[16] + (size_t)l * D * 2 * FFH; W.w_fo = A->in[17] + (size_t)l * FFH * D; W.pool_w = A->in[9] + (size_t)l * 4 * 128 * 128; W.pool_scale = A->in[10] + (size_t)l * 512; W.g_n1 = A->in[1] + (size_t)l * D; W.g_ssd = A->in[8] + (size_t)l * D; W.g_n2 = A->in[15] + (size_t)l * D;
            for (int rep = 0; rep <= DUP(0); ++rep) {
            phase_convert(F, W);
            if (l == 0) phase_prep(F, A->in[0], (bf16*)(F.ws + WS_XN), (float*)(F.ws + WS_PSS), M); }
        }
        SEAM(sb);
        for (int p = 0; p < NPASS; ++p) {
            const int s1 = sb + 1 + p * 5;
            if (PH(1) && RUN(s1)) {
                const CAS Args* A = kargs(); Frame F = mkframe(A, L); unsigned char* ws = F.ws;
                pg8::Gemm g{(const bf16*)(ws + WS_XN) + (size_t)p * MP * D, (const bf16*)(ws + WS_WIN), MP, INW_PAD, D}; ProjOrder S; S.init(F.G, F.bid, p == 0 ? M / 256 : 0);
                pg8::EpiProj E{ws, make_rstd_tab(S, (const float*)(ws + WS_PSS) + (size_t)p * MP * 4, F.lds, F.tid)};
                for (int rep = 0; rep <= DUP(1); ++rep) pg8::gemm_phase<pg8::EpiProj, ProjOrder, true, true>(F.lds, g, S, E);
            }
            SEAM(s1);
            if (PH(2) && RUN(s1 + 1)) {
                const CAS Args* A = kargs(); Frame F = mkframe(A, L); F.prow = (size_t)p * MP;
                phase_conv_own(F, A->in[3] + (size_t)l * 4 * 1536, A->in[4] + (size_t)l * 1536); phase_pool(F);
                phase_dsa(F, (bf16*)(F.ws + WS_YAP));
                asm volatile("s_waitcnt vmcnt(0)" ::: "memory"); __syncthreads();
                phase_ssd_states(F, A->in[5] + l * 16, A->in[6] + l * 16);
            }
            SEAM(s1 + 1);
#ifndef SSD_NAIVE
#ifndef SSDSUB
#define SSDSUB 7
#endif
            if (PH(3) && RUN(s1 + 2)) for (int rep = DUP(3); rep >= 0; --rep) {
                if (rep != DUP(3)) SEAM_ALWAYS();
                if (SSDSUB & 2) { const CAS Args* A = kargs(); Frame F = mkframe(A, L); phase_ssd_scan(F); }
                SEAM_ALWAYS();
                for (int r2 = DUP(15); r2 >= 0; --r2) { if (r2 != DUP(15)) SEAM_ALWAYS(); if (SSDSUB & 4) { const CAS Args* A = kargs(); Frame F = mkframe(A, L); F.prow = (size_t)p * MP; phase_ssd_out(F, A->in[5] + l * 16, A->in[6] + l * 16, A->in[7] + l * 16, (bf16*)(F.ws + ((rep || r2) ? WS_MERGED : WS_Z))); } }
            }
#endif
            SEAM(s1 + 2);
#ifndef MSUB
#define MSUB 7
#endif
            if (PH(5) && RUN(s1 + 3)) for (int rep = 0; rep <= DUP(5); ++rep) {
                const CAS Args* A = kargs(); Frame F = mkframe(A, L); unsigned char* ws = F.ws;
                pg8::Gemm g{(const bf16*)(ws + WS_Z), (const bf16*)(ws + WS_WUS), MP, D, D};
                MergeOrder S; S.S.init(MP, D, F.G, F.bid); S.A0 = (const char*)(ws + WS_Z); S.A1 = (const char*)(ws + WS_YAP); S.B0 = (const char*)(ws + WS_WUS); S.B1 = (const char*)(ws + WS_WUA);
                pg8::EpiMergeChain E{(const bf16*)(ws + WS_GATES), (bf16*)(ws + WS_MERGED), (const float*)(ws + WS_SSQ)};
                pg8::gemm_phase<pg8::EpiMergeChain, MergeOrder, true, true, true>(F.lds, g, S, E);
            }
            SEAM(s1 + 3);
            if (PH(6) && RUN(s1 + 4)) {
                const CAS Args* A = kargs(); Frame F = mkframe(A, L); unsigned char* ws = F.ws;
                pg8::Gemm g{(const bf16*)(ws + WS_MERGED), (const bf16*)(ws + WS_WOUT), MP, D, D}; pg8::StaticOrder S; S.init(MP, D, F.G, F.bid);
                pg8::EpiResid E{(bf16*)(ws + WS_XN) + (size_t)p * MP * D, (float*)(ws + WS_PSS) + (size_t)p * MP * 4, (LAS float*)(F.lds + DSA_X_OFF)};
                pg8::gemm_phase<pg8::EpiResid, pg8::StaticOrder, true, true>(F.lds, g, S, E);
            }
            if (p == NPASS - 1) SEAM(s1 + 4);
        }
        if (PH(8) && RUN(sb + 11)) {
            const CAS Args* A = kargs(); Frame F = mkframe(A, L); unsigned char* ws = F.ws;
            pg8::Gemm g{(const bf16*)(ws + WS_XN), (const bf16*)(ws + WS_WFI), M, 2 * FFH, D}; pg8::StaticOrder S; S.init(M, 2 * FFH, F.G, F.bid);
            pg8::EpiSwiGLU E{(bf16*)(ws + WS_ACT), FFH, make_rstd_tab(S, (const float*)(ws + WS_PSS), F.lds, F.tid)};
            for (int rep = 0; rep <= DUP(8); ++rep) pg8::gemm_phase<pg8::EpiSwiGLU, pg8::StaticOrder, true, true>(F.lds, g, S, E);
        }
        SEAM(sb + 11);
        if (PH(9) && RUN(sb + 12)) {
            const CAS Args* A = kargs(); Frame F = mkframe(A, L); unsigned char* ws = F.ws;
            pg8::Gemm g{(const bf16*)(ws + WS_ACT), (const bf16*)(ws + WS_WFO), M, D, FFH}; pg8::StaticOrder S; S.init(M, D, F.G, F.bid);
            pg8::EpiResid E{(bf16*)(ws + WS_XN), (float*)(ws + WS_PSS), (LAS float*)(F.lds + DSA_X_OFF)};
            pg8::gemm_phase<pg8::EpiResid, pg8::StaticOrder, true, true>(F.lds, g, S, E);
        }
        SEAM(sb + 12);
    }
    if (PH(10) && RUN(NL * 13)) { const CAS Args* A = kargs(); Frame F = mkframe(A, L); phase_final(F, (const bf16*)(F.ws + WS_XN), (const float*)(F.ws + WS_PSS), A->in[18], A->out, M); }
#undef RUN
#undef SEAM
}

#ifndef N_LAUNCH_SPLIT
#define N_LAUNCH_SPLIT 0
#endif
extern "C" void kernel_launch(void* const* d_in, const int* in_sizes, int n_in, void* d_out, int out_size, void* d_ws, size_t ws_size, hipStream_t stream) {
    static int grid = 0;
    if (grid == 0) {
        if (n_in != 19 || in_sizes[0] != M * D || out_size != M * D || ws_size < WS_END) { fprintf(stderr, "kernel_launch: unexpected shapes / workspace (n_in %d, in0 %d, out %d, ws %zu); nothing launched\n", n_in, n_in > 0 ? in_sizes[0] : -1, out_size, ws_size); grid = -1; return; }
        int dev = 0, cus = 0, per_cu = 0;
        if (hipGetDevice(&dev) != hipSuccess || hipDeviceGetAttribute(&cus, hipDeviceAttributeMultiprocessorCount, dev) != hipSuccess) { grid = -1; return; }
        if (hipFuncSetAttribute((const void*)trunk_fwd, hipFuncAttributeMaxDynamicSharedMemorySize, LDS_BYTES) != hipSuccess) { fprintf(stderr, "kernel_launch: hipFuncSetAttribute failed\n"); grid = -1; return; }
        if (hipOccupancyMaxActiveBlocksPerMultiprocessor(&per_cu, (const void*)trunk_fwd, NWAVES * 64, LDS_BYTES) != hipSuccess || per_cu < 1) { fprintf(stderr, "kernel_launch: occupancy query reports %d workgroups per CU\n", per_cu); }
        (void)hipGetLastError();
        grid = cus;
    }
    if (grid < 0) return;
    if (hipMemsetAsync((char*)d_ws + WS_CTL, 0, CTL_ZERO_BYTES, stream) != hipSuccess) return;
    Args a{};
    for (int i = 0; i < 19; ++i) a.in[i] = (const float*)d_in[i];
    a.out = (float*)d_out; a.ws = (unsigned char*)d_ws;
#if N_LAUNCH_SPLIT
    for (int s = 0; s < NSTEPS; ++s) { a.lo = s; a.hi = s + 1; hipLaunchKernelGGL(trunk_fwd, dim3(grid), dim3(NWAVES * 64), LDS_BYTES, stream, a); }
#else
    a.lo = 0; a.hi = NSTEPS; hipLaunchKernelGGL(trunk_fwd, dim3(grid), dim3(NWAVES * 64), LDS_BYTES, stream, a);
#endif
}
```

```cpp
#include <hip/hip_runtime.h>
#include <cstdio>
#include <cstdint>

constexpr int NB = 8, T = 4096, D = 1024, NL = 4, M = NB * T;
constexpr int NBP = 4, MP = NBP * T, NPASS = NB / NBP;
constexpr int INW = 7252, INW_PAD = 7424, FFH = 2816;
constexpr float EPS = 1e-6f;
constexpr size_t MiB = 1u << 20;
constexpr size_t WS_CTL = 0, CTL_ZERO_BYTES = 1 * MiB;
constexpr size_t WS_WIN = 2 * MiB, WS_WUS = 17 * MiB, WS_WUA = 19 * MiB, WS_WUP = 20 * MiB, WS_WOUT = 21 * MiB, WS_WFI = 23 * MiB, WS_WFO = 34 * MiB;
constexpr size_t WS_XN = 40 * MiB;
constexpr size_t WS_Z = 104 * MiB, WS_XBC = 136 * MiB, WS_Q = 184 * MiB, WS_KV = 200 * MiB, WS_QI = 208 * MiB, WS_U = 216 * MiB,
                 WS_GATES = 240 * MiB, WS_XBCC = 336 * MiB, WS_YAP = 384 * MiB, WS_MISC = 416 * MiB, WS_STATES = 432 * MiB, WS_DEC = 464 * MiB, WS_SSQ = 465 * MiB, WS_PSS = 466 * MiB, WS_KI = 468 * MiB, WS_MERGED = 472 * MiB, WS_END = 504 * MiB;
constexpr size_t WS_ACT = 104 * MiB;
static_assert(WS_ACT + (size_t)M * FFH * 2 <= WS_STATES, "ACT overlay");
namespace pg8 {
#define PG8_LAS __attribute__((address_space(3)))
typedef unsigned short bf16_t;
typedef short bf16x8 __attribute__((ext_vector_type(8)));
typedef float f32x4 __attribute__((ext_vector_type(4)));
typedef unsigned u32x4 __attribute__((ext_vector_type(4)));
constexpr int BM = 256, BK = 64, HALF = 128, HTB = HALF * BK * 2  , STAGE_BYTES = 8 * HTB, NXCD = 8, WGM = 8;

__host__ __device__ __forceinline__ int lds_byte(int r, int c) { const int st = (r >> 4) * 2 + (c >> 5), rr = r & 15, cc = c & 31, ob = rr * 64 + cc * 2; return st * 1024 + (ob ^ (((ob >> 9) & 1) << 5)); }
__host__ __device__ __forceinline__ void stage_rc(int b, int& R, int& C) { const int st = b / 1024, sb = b % 1024, swz = sb ^ (((sb >> 9) & 1) << 5); R = (st >> 1) * 16 + swz / 64; C = (st & 1) * 32 + (swz % 64) / 2; }
__host__ __device__ __forceinline__ int perm32(int rho) { const int n = rho >> 4, i = rho & 15; return 8 * (i >> 2) + 4 * n + (i & 3); }

struct Unit { int pm, pn, br; };
struct Gemm { const bf16_t* A; const bf16_t* Bt; int M, N, K; };

struct StaticOrder {
    int nM, nN, nwg, G, c;
    __host__ __device__ void init(int M, int N, int G_, int c_) { nM = M / BM; nN = N / BM; nwg = nM * nN; G = G_; c = c_; }
    __host__ __device__ bool next(int i, Unit& u) const {
        const long L = (long)i * G + c; if (L >= nwg) return false;
        int wgid = (int)L; { const int q = nwg / NXCD, r = nwg % NXCD, xcd = wgid % NXCD, off = wgid / NXCD; wgid = (xcd < r ? xcd * (q + 1) : r * (q + 1) + (xcd - r) * q) + off; }
        const int nig = WGM * nN, gid = wgid / nig, fm = gid * WGM, gsz = (nM - fm) < WGM ? (nM - fm) : WGM;
        u.pm = fm + ((wgid % nig) % gsz); u.pn = (wgid % nig) / gsz; return true;
    }
    __device__ __forceinline__ void a_ready(const Unit&) const {}
    __device__ __forceinline__ void done(const Unit&) const {}
};

__device__ __forceinline__ unsigned cvt_pk_bf16(float lo, float hi) { unsigned r; asm volatile("v_cvt_pk_bf16_f32 %0, %1, %2" : "=v"(r) : "v"(lo), "v"(hi)); return r; }
typedef float f32x2 __attribute__((ext_vector_type(2)));
__device__ __forceinline__ float xsum16(float x) { const auto r = __builtin_amdgcn_permlane16_swap(__builtin_bit_cast(unsigned, x), __builtin_bit_cast(unsigned, x), false, false); return __builtin_bit_cast(float, (unsigned)r[0]) + __builtin_bit_cast(float, (unsigned)r[1]); }
__device__ __forceinline__ float xsum32(float x) { const auto r = __builtin_amdgcn_permlane32_swap(__builtin_bit_cast(unsigned, x), __builtin_bit_cast(unsigned, x), false, false); return __builtin_bit_cast(float, (unsigned)r[0]) + __builtin_bit_cast(float, (unsigned)r[1]); }
__device__ __forceinline__ float xmax16(float x) { const auto r = __builtin_amdgcn_permlane16_swap(__builtin_bit_cast(unsigned, x), __builtin_bit_cast(unsigned, x), false, false); return fmaxf(__builtin_bit_cast(float, (unsigned)r[0]), __builtin_bit_cast(float, (unsigned)r[1])); }
__device__ __forceinline__ float xmax32(float x) { const auto r = __builtin_amdgcn_permlane32_swap(__builtin_bit_cast(unsigned, x), __builtin_bit_cast(unsigned, x), false, false); return fmaxf(__builtin_bit_cast(float, (unsigned)r[0]), __builtin_bit_cast(float, (unsigned)r[1])); }
__device__ __forceinline__ float bf_lo(unsigned w) { return __uint_as_float(w << 16); }
__device__ __forceinline__ float bf_hi(unsigned w) { return __uint_as_float(w & 0xffff0000u); }
__device__ __forceinline__ float sigm(float x) { return __builtin_amdgcn_rcpf(1.0f + __expf(-x)); }
__device__ __forceinline__ float row_rstd(const float* p4) { const f32x4 a = *(const f32x4*)p4; return __builtin_amdgcn_rsqf(((a[0] + a[1]) + (a[2] + a[3])) * (1.0f / 1024.0f) + 1e-6f); }
__device__ __forceinline__ float row_rstd2(const float* p2) { typedef float f32x2v __attribute__((ext_vector_type(2))); const f32x2v a = *(const f32x2v*)p2; return __builtin_amdgcn_rsqf((a[0] + a[1]) * (1.0f / 1024.0f) + 1e-6f); }

struct RstdTab { const PG8_LAS float* tab; int pmA, pmB; const float* pss;
    __device__ __forceinline__ float get(int pm, int rl) const { return pm == pmA ? tab[rl] : (pm == pmB ? tab[BM + rl] : row_rstd(pss + (size_t)(pm * BM + rl) * 4)); } };
struct EpiProj {
    static constexpr bool PERM = true, AFTER_DRAIN = false;
    unsigned char* ws; RstdTab rt;
    __device__ __forceinline__ void operator()(const f32x4 (&acc)[2][2][4][2], const Unit& u, int wr, int wc, int fr, int fq) const {
        const int pn = u.pn; size_t off; int ldc, c0;
        if (pn < 4)       { off = WS_Z;     ldc = 1024; c0 = pn * 256; }
        else if (pn < 10) { off = WS_XBC;   ldc = 1536; c0 = (pn - 4) * 256; }
        else if (pn < 12) { off = WS_Q;     ldc = 512;  c0 = (pn - 10) * 256; }
        else if (pn < 13) { off = WS_KV;    ldc = 256;  c0 = 0; }
        else if (pn < 14) { off = WS_QI;    ldc = 256;  c0 = 0; }
        else if (pn < 16) { off = WS_U;     ldc = 512;  c0 = (pn - 14) * 256; }
        else if (pn < 28) { off = WS_GATES; ldc = 3072; c0 = (pn - 16) * 256; }
        else              { off = WS_MISC;  ldc = 256;  c0 = 0; }
        bf16_t* base = (bf16_t*)(ws + off);
        const int row0 = u.pm * BM + wr * 64 + fr, col0 = c0 + wc * 32 + 8 * fq;
        float rsv[2][4];
#pragma unroll
        for (int ai = 0; ai < 2; ++ai)
#pragma unroll
            for (int m = 0; m < 4; ++m) rsv[ai][m] = rt.get(u.pm, wr * 64 + fr + ai * HALF + m * 16);
#pragma unroll
        for (int ai = 0; ai < 2; ++ai)
#pragma unroll
            for (int m = 0; m < 4; ++m) { const int row = row0 + ai * HALF + m * 16; bf16_t* rowp = base + (size_t)row * ldc + col0; const float rs = rsv[ai][m];
#pragma unroll
                for (int bj = 0; bj < 2; ++bj) { const f32x4 v0 = acc[ai][bj][m][0] * rs, v1 = acc[ai][bj][m][1] * rs;
                    u32x4 w; w.x = cvt_pk_bf16(v0[0], v0[1]); w.y = cvt_pk_bf16(v0[2], v0[3]); w.z = cvt_pk_bf16(v1[0], v1[1]); w.w = cvt_pk_bf16(v1[2], v1[3]);
                    if (pn == 28 && bj == 0 && wc < 2) *(u32x4*)((bf16_t*)(ws + WS_KI) + (size_t)row * 64 + col0) = w;
                    if (pn != 28 || (bj == 0 && wc == 2)) __builtin_nontemporal_store(w, (u32x4*)(rowp + bj * HALF));
#if defined(DUP_MASK) && ((DUP_MASK >> 13) & 1)
                    { const size_t o2 = ((size_t)((const char*)(rowp + bj * HALF) - (const char*)ws)) & (32 * MiB - 1); *(u32x4*)(ws + WS_STATES + o2) = w; }
#endif
                    } }
    }
};
struct EpiSwiGLU {
    static constexpr bool PERM = true, AFTER_DRAIN = false;
    bf16_t* O; int ldc; RstdTab rt;
    __device__ __forceinline__ void operator()(const f32x4 (&acc)[2][2][4][2], const Unit& u, int wr, int wc, int fr, int fq) const {
        const int row0 = u.pm * BM + wr * 64 + fr, col0 = u.pn * HALF + wc * 32 + 8 * fq;
        float rsv[2][4];
#pragma unroll
        for (int ai = 0; ai < 2; ++ai)
#pragma unroll
            for (int m = 0; m < 4; ++m) rsv[ai][m] = rt.get(u.pm, wr * 64 + fr + ai * HALF + m * 16);
#pragma unroll
        for (int ai = 0; ai < 2; ++ai)
#pragma unroll
            for (int m = 0; m < 4; ++m) { const int row = row0 + ai * HALF + m * 16; bf16_t* rowp = O + (size_t)row * ldc + col0; const float rs = rsv[ai][m];
                float r[8];
#pragma unroll
                for (int n = 0; n < 2; ++n)
#pragma unroll
                    for (int i = 0; i < 4; ++i) { const float a = acc[ai][0][m][n][i] * rs, b = acc[ai][1][m][n][i] * rs; r[n * 4 + i] = a * sigm(a) * b; }
                u32x4 w; w.x = cvt_pk_bf16(r[0], r[1]); w.y = cvt_pk_bf16(r[2], r[3]); w.z = cvt_pk_bf16(r[4], r[5]); w.w = cvt_pk_bf16(r[6], r[7]);
                *(u32x4*)rowp = w; }
    }
};
struct EpiResid {
    static constexpr bool PERM = true, AFTER_DRAIN = false;
    bf16_t* xn; float* pss; PG8_LAS float* part;
    __device__ __forceinline__ void operator()(const f32x4 (&acc)[2][2][4][2], const Unit& u, int wr, int wc, int fr, int fq) const {
        const int row0 = u.pm * BM + wr * 64 + fr, col0 = u.pn * BM + wc * 32 + 8 * fq;
#pragma unroll
        for (int ai = 0; ai < 2; ++ai) {
            u32x4 hw[4][2];
#pragma unroll
            for (int m = 0; m < 4; ++m)
#pragma unroll
                for (int bj = 0; bj < 2; ++bj) hw[m][bj] = *(const u32x4*)(xn + (size_t)(row0 + ai * HALF + m * 16) * 1024 + col0 + bj * HALF);
#pragma unroll
            for (int m = 0; m < 4; ++m) { bf16_t* rowp = xn + (size_t)(row0 + ai * HALF + m * 16) * 1024 + col0; float ss = 0.f;
#pragma unroll
                for (int bj = 0; bj < 2; ++bj) { const u32x4 h4 = hw[m][bj]; const f32x4 v0 = acc[ai][bj][m][0], v1 = acc[ai][bj][m][1];
                    float r[8];
                    r[0] = bf_lo(h4.x) + v0[0]; r[1] = bf_hi(h4.x) + v0[1]; r[2] = bf_lo(h4.y) + v0[2]; r[3] = bf_hi(h4.y) + v0[3];
                    r[4] = bf_lo(h4.z) + v1[0]; r[5] = bf_hi(h4.z) + v1[1]; r[6] = bf_lo(h4.w) + v1[2]; r[7] = bf_hi(h4.w) + v1[3];
                    ss += ((r[0] * r[0] + r[1] * r[1]) + (r[2] * r[2] + r[3] * r[3])) + ((r[4] * r[4] + r[5] * r[5]) + (r[6] * r[6] + r[7] * r[7]));
                    u32x4 w; w.x = cvt_pk_bf16(r[0], r[1]); w.y = cvt_pk_bf16(r[2], r[3]); w.z = cvt_pk_bf16(r[4], r[5]); w.w = cvt_pk_bf16(r[6], r[7]);
                    *(u32x4*)(rowp + bj * HALF) = w; }
                ss = xsum32(xsum16(ss));
                if (fq == 0) part[(ai * HALF + wr * 64 + m * 16 + fr) * 4 + wc] = ss; }
        }
        asm volatile("s_waitcnt lgkmcnt(0)" ::: "memory"); __builtin_amdgcn_s_barrier(); asm volatile("" ::: "memory");
        int t = threadIdx.x; asm volatile("" : "+v"(t));
        if (t < BM) { const f32x4 q = *(const PG8_LAS f32x4*)(part + t * 4); pss[(size_t)(u.pm * BM + t) * 4 + u.pn] = (q[0] + q[1]) + (q[2] + q[3]); }
    }
};
__device__ __forceinline__ float gexp(float g) { return __builtin_amdgcn_exp2f(__builtin_amdgcn_fmed3f(g, -43.2808512f, 43.2808512f)); }
__device__ __forceinline__ float gratio(float gn, float gd) { return (1.0f + gexp(gd)) * __builtin_amdgcn_rcpf(1.0f + gexp(gn)); }
__device__ __forceinline__ float gsig(float g) { return __builtin_amdgcn_rcpf(1.0f + gexp(g)); }
struct EpiMergeChain {
    static constexpr bool PERM = true, AFTER_DRAIN = false;
    const bf16_t* gates; bf16_t* P; const float* ssq;
    __device__ __forceinline__ void operator()(f32x4 (&acc)[2][2][4][2], const Unit& u, int wr, int wc, int fr, int fq) const {
        const int row0 = u.pm * BM + wr * 64 + fr, col0 = u.pn * BM + wc * 32 + 8 * fq;
        if (u.br < 2) {
            const bf16_t* gn = gates + u.br * 1024; const bool first = u.br == 0;
#pragma unroll
            for (int ai = 0; ai < 2; ++ai)
#pragma unroll
                for (int m = 0; m < 4; ++m) { const size_t row = (size_t)(row0 + ai * HALF + m * 16); const float rs = first ? row_rstd2(ssq + row * 2) : 1.0f;
#pragma unroll
                    for (int bj = 0; bj < 2; ++bj) { const u32x4 x = *(const u32x4*)(gn + row * 3072 + col0 + bj * HALF), y = *(const u32x4*)(gn + 1024 + row * 3072 + col0 + bj * HALF);
                        { const f32x4 r0 = (f32x4){gratio(bf_lo(x.x), bf_lo(y.x)), gratio(bf_hi(x.x), bf_hi(y.x)), gratio(bf_lo(x.y), bf_lo(y.y)), gratio(bf_hi(x.y), bf_hi(y.y))};
                          acc[ai][bj][m][0] = acc[ai][bj][m][0] * (r0 * rs); asm volatile("" : "+v"(acc[ai][bj][m][0])); }
                        { const f32x4 r1 = (f32x4){gratio(bf_lo(x.z), bf_lo(y.z)), gratio(bf_hi(x.z), bf_hi(y.z)), gratio(bf_lo(x.w), bf_lo(y.w)), gratio(bf_hi(x.w), bf_hi(y.w))};
                          acc[ai][bj][m][1] = acc[ai][bj][m][1] * (r1 * rs); asm volatile("" : "+v"(acc[ai][bj][m][1])); } }
                    asm volatile("" ::: "memory"); }
        } else {
            const bf16_t* g3 = gates + 2048;
#pragma unroll
            for (int ai = 0; ai < 2; ++ai)
#pragma unroll
                for (int m = 0; m < 4; ++m) { const size_t row = (size_t)(row0 + ai * HALF + m * 16);
#pragma unroll
                    for (int bj = 0; bj < 2; ++bj) { const u32x4 x = *(const u32x4*)(g3 + row * 3072 + col0 + bj * HALF); const f32x4 v0 = acc[ai][bj][m][0], v1 = acc[ai][bj][m][1];
                        u32x4 w; w.x = cvt_pk_bf16(v0[0] * gsig((bf_lo(x.x))), v0[1] * gsig((bf_hi(x.x)))); w.y = cvt_pk_bf16(v0[2] * gsig((bf_lo(x.y))), v0[3] * gsig((bf_hi(x.y))));
                        w.z = cvt_pk_bf16(v1[0] * gsig((bf_lo(x.z))), v1[1] * gsig((bf_hi(x.z)))); w.w = cvt_pk_bf16(v1[2] * gsig((bf_lo(x.w))), v1[3] * gsig((bf_hi(x.w))));
                        *(u32x4*)(P + row * 1024 + col0 + bj * HALF) = w; }
                    if (m & 1) asm volatile("" ::: "memory"); }
        }
    }
};

template <class Epi, class Sched, bool ALIGN_EPI = false, bool SP2 = false, bool HET = false>
__device__ __forceinline__ void gemm_phase(PG8_LAS unsigned char* lds, const Gemm g, const Sched& S, const Epi& E) {
    int tid_ = threadIdx.x; asm volatile("" : "+v"(tid_));
    const int tid = tid_, wid = __builtin_amdgcn_readfirstlane(tid >> 6), lane = tid & 63, wr = wid >> 2, wc = wid & 3, fr = lane & 15, fq = lane >> 4;
    const int K = g.K; int nt = K / BK;
    unsigned voffA[2], voffB[2];
#pragma unroll
    for (int i = 0; i < 2; ++i) { int R, C; stage_rc(tid * 16 + i * 8192, R, C); const int Rb = Epi::PERM ? ((R & ~31) + perm32(R & 31)) : R;
        voffA[i] = (unsigned)(R * K + C) * 2u; voffB[i] = (unsigned)(Rb * K + C) * 2u; }
    const size_t kstep = (size_t)(BK * 2);
    const size_t hstep = (size_t)HALF * K * 2;
    const size_t tstep = 2 * hstep;
    const unsigned ldsw = (unsigned)wid * 1024u;
    const int aoff = lds_byte(wr * 64 + fr, fq * 8), boff = lds_byte(wc * 32 + fr, fq * 8);
#define PG8_SA(b, h) (((b) * 2 + (h)) * HTB)
#define PG8_SB(b, h) ((4 + (b) * 2 + (h)) * HTB)
#define PG8_STAGE(bufoff, gbase, voff) do { _Pragma("unroll") for (int _i = 0; _i < 2; ++_i) \
        __builtin_amdgcn_global_load_lds((const unsigned*)((const char*)(gbase) + (voff)[_i]), (PG8_LAS unsigned*)(lds + (bufoff) + ldsw + _i * 8192), 16, 0, 0); } while (0)
#define PG8_LDA(dst, b, h) do { _Pragma("unroll") for (int m = 0; m < 4; ++m) _Pragma("unroll") for (int k = 0; k < 2; ++k) dst[m][k] = *(const PG8_LAS bf16x8*)(lds + PG8_SA(b, h) + aoff + m * 2048 + k * 1024); } while (0)
#define PG8_LDB(dst, b, h) do { _Pragma("unroll") for (int n = 0; n < 2; ++n) _Pragma("unroll") for (int k = 0; k < 2; ++k) dst[n][k] = *(const PG8_LAS bf16x8*)(lds + PG8_SB(b, h) + boff + n * 2048 + k * 1024); } while (0)
#define PG8_MMA(ai, bj, At, Bt) do { __builtin_amdgcn_s_setprio(1); _Pragma("unroll") for (int m = 0; m < 4; ++m) _Pragma("unroll") for (int n = 0; n < 2; ++n) _Pragma("unroll") for (int k = 0; k < 2; ++k) \
        acc[ai][bj][m][n] = __builtin_amdgcn_mfma_f32_16x16x32_bf16(Bt[n][k], At[m][k], acc[ai][bj][m][n], 0, 0, 0); __builtin_amdgcn_s_setprio(0); } while (0)
#define PG8_WAIT_V(n) asm volatile("s_waitcnt vmcnt(" #n ")" ::: "memory")
#define PG8_WAIT_L(n) asm volatile("s_waitcnt lgkmcnt(" #n ")" ::: "memory")
#define PG8_BAR __builtin_amdgcn_s_barrier()
#define PG8_SCHED __builtin_amdgcn_sched_barrier(0)
    Unit cur, nxt; int ui = 0;
    if (!S.next(0, cur)) return;
    f32x4 acc[2][2][4][2];
#pragma unroll
    for (int a = 0; a < 2; ++a)
#pragma unroll
        for (int b = 0; b < 2; ++b)
#pragma unroll
            for (int m = 0; m < 4; ++m)
#pragma unroll
                for (int n = 0; n < 2; ++n) acc[a][b][m][n] = (f32x4){0.f, 0.f, 0.f, 0.f};
    bf16x8 At[4][2], B0[2][2], B1[2][2];
    const char* cA = (const char*)g.A + (size_t)cur.pm * tstep; const char* cB = (const char*)g.Bt + (size_t)cur.pn * tstep;
    if constexpr (HET) { cA = S.abase(cur) + (size_t)cur.pm * tstep; cB = S.bbase(cur) + (size_t)cur.pn * tstep; nt = S.nt(cur); }
    S.a_ready(cur);
    if constexpr (SP2) {
        PG8_STAGE(PG8_SB(0, 0), cB, voffB); PG8_STAGE(PG8_SB(0, 1), cB + hstep, voffB); PG8_STAGE(PG8_SA(0, 0), cA, voffA); PG8_STAGE(PG8_SA(0, 1), cA + hstep, voffA);
        if (wr == 1) PG8_BAR;
        PG8_WAIT_V(2); PG8_BAR;
        PG8_STAGE(PG8_SB(1, 0), cB + kstep, voffB); PG8_STAGE(PG8_SA(1, 0), cA + kstep, voffA); PG8_STAGE(PG8_SB(1, 1), cB + hstep + kstep, voffB);
        PG8_WAIT_V(6); PG8_BAR;
    } else {
        PG8_STAGE(PG8_SB(0, 0), cB, voffB); PG8_STAGE(PG8_SA(0, 0), cA, voffA); PG8_STAGE(PG8_SB(0, 1), cB + hstep, voffB); PG8_STAGE(PG8_SA(0, 1), cA + hstep, voffA);
        if (wr == 1) PG8_BAR;
        PG8_WAIT_V(4); PG8_BAR;
        PG8_STAGE(PG8_SB(1, 0), cB + kstep, voffB); PG8_STAGE(PG8_SA(1, 0), cA + kstep, voffA); PG8_STAGE(PG8_SB(1, 1), cB + hstep + kstep, voffB);
        PG8_WAIT_V(6); PG8_BAR;
    }
    for (;;) {
        const bool has_next = S.next(ui + 1, nxt);
        const char* nA = has_next ? (const char*)g.A + (size_t)nxt.pm * tstep : cA; const char* nB = has_next ? (const char*)g.Bt + (size_t)nxt.pn * tstep : cB;
        if constexpr (HET) { if (has_next) { nA = S.abase(nxt) + (size_t)nxt.pm * tstep; nB = S.bbase(nxt) + (size_t)nxt.pn * tstep; } }
        for (int t = 0; t < nt; t += 2) {
            const bool last = (t == nt - 2);
            const char* a1 = cA + (size_t)(t + 1) * kstep;
            const char* a2 = last ? nA : cA + (size_t)(t + 2) * kstep; const char* b2 = last ? nB : cB + (size_t)(t + 2) * kstep;
            const char* a3 = a2 + kstep; const char* b3 = b2 + kstep;
            if (last && has_next) S.a_ready(nxt);
            if constexpr (SP2) {
            PG8_LDB(B0, 0, 0); PG8_LDB(B1, 0, 1); PG8_SCHED; PG8_LDA(At, 0, 0); PG8_STAGE(PG8_SA(1, 1), a1 + hstep, voffA);
            PG8_WAIT_V(8); PG8_WAIT_L(0); PG8_BAR; PG8_MMA(0, 0, At, B0); PG8_MMA(0, 1, At, B1); PG8_BAR; PG8_SCHED;
            PG8_LDA(At, 0, 1); PG8_STAGE(PG8_SB(0, 0), b2, voffB); PG8_STAGE(PG8_SB(0, 1), b2 + hstep, voffB); PG8_STAGE(PG8_SA(0, 0), a2, voffA);
            PG8_WAIT_V(8); PG8_WAIT_L(0); PG8_BAR; PG8_MMA(1, 0, At, B0); PG8_MMA(1, 1, At, B1); PG8_BAR; PG8_SCHED;
            PG8_LDB(B0, 1, 0); PG8_LDB(B1, 1, 1); PG8_SCHED; PG8_LDA(At, 1, 0); PG8_STAGE(PG8_SA(0, 1), a2 + hstep, voffA);
            PG8_WAIT_V(8); PG8_WAIT_L(0); PG8_BAR; PG8_MMA(0, 0, At, B0); PG8_MMA(0, 1, At, B1); PG8_BAR; PG8_SCHED;
            PG8_LDA(At, 1, 1); PG8_STAGE(PG8_SB(1, 0), b3, voffB); PG8_STAGE(PG8_SB(1, 1), b3 + hstep, voffB); PG8_STAGE(PG8_SA(1, 0), a3, voffA);
            PG8_WAIT_V(8); PG8_WAIT_L(0); PG8_BAR; PG8_MMA(1, 0, At, B0); PG8_MMA(1, 1, At, B1); PG8_BAR; PG8_SCHED;
            } else {
            PG8_LDB(B0, 0, 0); PG8_SCHED; PG8_LDA(At, 0, 0); PG8_STAGE(PG8_SA(1, 1), a1 + hstep, voffA);
            PG8_WAIT_L(8); PG8_BAR; PG8_WAIT_L(0); PG8_MMA(0, 0, At, B0); PG8_BAR; PG8_SCHED;
            PG8_LDB(B1, 0, 1); PG8_STAGE(PG8_SB(0, 0), b2, voffB);
            PG8_BAR; PG8_WAIT_L(0); PG8_MMA(0, 1, At, B1); PG8_BAR;
            PG8_LDA(At, 0, 1); PG8_STAGE(PG8_SA(0, 0), a2, voffA);
            PG8_BAR; PG8_WAIT_L(0); PG8_MMA(1, 0, At, B0); PG8_BAR; PG8_SCHED;
            PG8_STAGE(PG8_SB(0, 1), b2 + hstep, voffB);
            PG8_WAIT_V(6); PG8_BAR; PG8_MMA(1, 1, At, B1); PG8_BAR;
            PG8_LDB(B0, 1, 0); PG8_SCHED; PG8_LDA(At, 1, 0); PG8_STAGE(PG8_SA(0, 1), a2 + hstep, voffA);
            PG8_WAIT_L(8); PG8_BAR; PG8_WAIT_L(0); PG8_MMA(0, 0, At, B0); PG8_BAR; PG8_SCHED;
            PG8_LDB(B1, 1, 1); PG8_STAGE(PG8_SB(1, 0), b3, voffB);
            PG8_BAR; PG8_WAIT_L(0); PG8_MMA(0, 1, At, B1); PG8_BAR;
            PG8_LDA(At, 1, 1); PG8_STAGE(PG8_SA(1, 0), a3, voffA);
            PG8_BAR; PG8_WAIT_L(0); PG8_MMA(1, 0, At, B0); PG8_BAR; PG8_SCHED;
            PG8_STAGE(PG8_SB(1, 1), b3 + hstep, voffB);
            PG8_WAIT_V(6); PG8_BAR; PG8_MMA(1, 1, At, B1); PG8_BAR;
            }
        }
        if constexpr (ALIGN_EPI) { if (wr == 0) PG8_BAR; }
        if constexpr (!Epi::AFTER_DRAIN) { E(acc, cur, wr, wc, fr, fq); S.done(cur); }
        if (!has_next) break;
        bool clr = true; if constexpr (HET) clr = S.fresh(nxt);
        if (clr)
#pragma unroll
        for (int a = 0; a < 2; ++a)
#pragma unroll
            for (int b = 0; b < 2; ++b)
#pragma unroll
                for (int m = 0; m < 4; ++m)
#pragma unroll
                    for (int n = 0; n < 2; ++n) acc[a][b][m][n] = (f32x4){0.f, 0.f, 0.f, 0.f};
        cur = nxt; cA = nA; cB = nB; ++ui;
        if constexpr (HET) nt = S.nt(cur);
        if constexpr (ALIGN_EPI) { if (wr == 1) PG8_BAR; }
    }
    PG8_WAIT_V(0);
    if constexpr (!ALIGN_EPI) { if (wr == 0) PG8_BAR; }
    PG8_BAR;
    if constexpr (Epi::AFTER_DRAIN) { E.fused(acc, cur, wr, wc, fr, fq, lds, wid, lane); S.done(cur); }
#undef PG8_SA
#undef PG8_SB
#undef PG8_STAGE
#undef PG8_LDA
#undef PG8_LDB
#undef PG8_MMA
#undef PG8_WAIT_V
#undef PG8_WAIT_L
#undef PG8_BAR
#undef PG8_SCHED
}
}
#define GAS __attribute__((address_space(1)))
#define LAS __attribute__((address_space(3)))
typedef unsigned short bf16;
typedef unsigned v4u __attribute__((ext_vector_type(4)));
typedef float f32x4 __attribute__((ext_vector_type(4)));
typedef short bf16x8 __attribute__((ext_vector_type(8)));
typedef GAS unsigned gu32;
typedef GAS unsigned long long gu64;
#define RLX_AGENT __ATOMIC_RELAXED, __HIP_MEMORY_SCOPE_AGENT
#define LDS_WAIT() asm volatile("s_waitcnt lgkmcnt(0)" ::: "memory")
#define VM_WAIT() asm volatile("s_waitcnt vmcnt(0)" ::: "memory")
__device__ __forceinline__ unsigned long long rt() { return __builtin_amdgcn_s_memrealtime(); }
__device__ __forceinline__ unsigned f2bf(float f) { unsigned u = __builtin_bit_cast(unsigned, f); return (u + 0x7fffu + ((u >> 16) & 1u)) >> 16; }
__device__ __forceinline__ unsigned pk2(float lo, float hi) { return f2bf(lo) | (f2bf(hi) << 16); }

#define XB_TMO      128
#define XB_XCNT(j)  (256  + 64 * (j))
#define XB_XSUB(j)  (1280 + 64 * (j))
#define XB_XGEN(j)  (2304 + 64 * (j))
#define XB_TOP      3328
#define XB_TOPGEN   3392
#define XCD_BAR_WORDS 3456
#define XB_SPIN_CAP (1u << 18)

__device__ __forceinline__ unsigned xb_ld(unsigned* p)              { return __hip_atomic_load(p, __ATOMIC_RELAXED, __HIP_MEMORY_SCOPE_AGENT); }
__device__ __forceinline__ unsigned xb_add(unsigned* p, unsigned v) { return __hip_atomic_fetch_add(p, v, __ATOMIC_RELAXED, __HIP_MEMORY_SCOPE_AGENT); }
__device__ __forceinline__ unsigned xb_xcc_id() { return (unsigned)__builtin_amdgcn_s_getreg((3 << 11) | 20) & 0xFu; }
#define XB_SPIN(cond, bar) do { unsigned _sp = 0; while (cond) { __builtin_amdgcn_s_sleep(1); \
    if ((++_sp & 255u) == 0u) { if (xb_ld(&(bar)[XB_TMO])) break; if (_sp > XB_SPIN_CAP) { atomicAdd(&(bar)[XB_TMO], 1u); break; } } } } while (0)

struct XcdBarrier {
    unsigned* bar; unsigned x;
    volatile LAS unsigned* st;
};

__device__ __forceinline__ XcdBarrier xcd_barrier_post(unsigned* bar, volatile LAS unsigned* st) {
    XcdBarrier b; b.bar = bar; b.x = xb_xcc_id(); b.st = st;
    if (threadIdx.x == 0) (void)xb_add(&bar[XB_XCNT(b.x)], 1u);
    return b;
}
__device__ __forceinline__ void xcd_barrier_complete(unsigned* bar, unsigned x, unsigned& nloc, unsigned& nx) {
    const unsigned G = gridDim.x * gridDim.y * gridDim.z;
    unsigned sum, cnt, mine, sp = 0u;
    for (;;) {
        sum = 0u; cnt = 0u; mine = 0u;
#pragma unroll
        for (unsigned j = 0; j < 16; ++j) { const unsigned c = xb_ld(&bar[XB_XCNT(j)]); sum += c; cnt += (c > 0u) ? 1u : 0u; mine = (j == x) ? c : mine; }
        if (sum == G) break;
        __builtin_amdgcn_s_sleep(1);
        if ((++sp & 255u) == 0u) { if (xb_ld(&bar[XB_TMO])) break; if (sp > XB_SPIN_CAP) { atomicAdd(&bar[XB_TMO], 1u); break; } }
    }
    nloc = mine > 0u ? mine : 1u; nx = cnt > 0u ? cnt : 1u;
}

__device__ __forceinline__ void xcd_barrier(const XcdBarrier& b) {
    asm volatile("s_waitcnt vmcnt(0)" ::: "memory");
    __syncthreads();
    if (threadIdx.x == 0) {
        unsigned* bar = b.bar;
        __builtin_amdgcn_s_waitcnt(0);
        unsigned nloc = b.st[0], nx = b.st[1];
        if (nloc == 0u) { xcd_barrier_complete(bar, b.x, nloc, nx); b.st[0] = nloc; b.st[1] = nx; }
        const unsigned old = xb_add(&bar[XB_XSUB(b.x)], 1u);
        const unsigned gen = old / nloc;
        if (old + 1u == (gen + 1u) * nloc) {
            __builtin_amdgcn_fence(__ATOMIC_RELEASE, "agent");
            asm volatile("s_waitcnt vmcnt(0)" ::: "memory");
            const unsigned og = xb_add(&bar[XB_TOP], 1u);
            const unsigned tg = og / nx;
            if (og + 1u == (tg + 1u) * nx) xb_add(&bar[XB_TOPGEN], 1u);
            else XB_SPIN(xb_ld(&bar[XB_TOPGEN]) == tg, bar);
            __builtin_amdgcn_fence(__ATOMIC_ACQUIRE, "agent");
            xb_add(&bar[XB_XGEN(b.x)], 1u);
            asm volatile("s_waitcnt vmcnt(0)" ::: "memory");
        } else {
            XB_SPIN(xb_ld(&bar[XB_XGEN(b.x)]) == gen, bar);
            __builtin_amdgcn_fence(__ATOMIC_ACQUIRE, "agent");
            asm volatile("s_waitcnt vmcnt(0)" ::: "memory");
        }
    }
    __syncthreads();
}
constexpr int NWAVES = 8;
constexpr int RING_BYTES = 131072;
constexpr int LDSCTL_OFF = 155648 - 512, MISC_OFF = LDSCTL_OFF + 320;
constexpr int DSA_X_OFF = 139264;
constexpr int LDS_BYTES = 155648;
static_assert(DSA_X_OFF + 8 * 1024 + 8 * 512 <= LDS_BYTES - 512, "LDS map");
constexpr int NSTEPS = NL * 13 + 1;


struct Frame {
    LAS unsigned char* lds;
    volatile LAS unsigned* MISC;
    gu32* ctl;
    int tid, lane, wave, G, bid;
    unsigned char* ws;
    size_t prow;
};
__device__ __forceinline__ float bf2f(unsigned short b) { return __uint_as_float((unsigned)b << 16); }
#define pk2(lo_, hi_) pg8::cvt_pk_bf16((lo_), (hi_))
__device__ __forceinline__ float wave_sum(float v) {
#pragma unroll
    for (int o = 32; o >= 1; o >>= 1) v += __shfl_xor(v, o);
    return v;
}
__device__ __forceinline__ float wave_max(float v) {
#pragma unroll
    for (int o = 32; o >= 1; o >>= 1) v = fmaxf(v, __shfl_xor(v, o));
    return v;
}
__device__ __forceinline__ float silu_f(float x) { return x * __builtin_amdgcn_rcpf(1.0f + __expf(-x)); }
constexpr unsigned RS = 272;
typedef short s16x4 __attribute__((ext_vector_type(4)));
typedef short v4i16_t __attribute__((ext_vector_type(4)));
#define WAVE_LDS_FENCE() do { asm volatile("s_waitcnt lgkmcnt(0)" ::: "memory"); __builtin_amdgcn_wave_barrier(); asm volatile("" ::: "memory"); } while (0)

__device__ __forceinline__ int src_in(int r) {
    if (r < 2560) return r;
    if (r < 3072) return 2576 + (r - 2560);
    if (r < 3200) return 3088 + (r - 3072);
    if (r < 3328) return 3216 + (r - 3200);
    if (r < 3584) return 3344 + (r - 3328);
    if (r < 4096) return 3668 + (r - 3584);
    if (r < 7168) return 4180 + (r - 4096);
    if (r < 7232) return 3600 + (r - 7168);
    if (r < 7248) return 2560 + (r - 7232);
    if (r < 7252) return 3664 + (r - 7248);
    return -1;
}
__device__ __forceinline__ int src_ffi(int r) { const int t = r >> 8, w = r & 255; return w < 128 ? t * 128 + w : FFH + t * 128 + (w - 128); }
template <int MODE>
__device__ __forceinline__ void cvt_item(const float* W, int ldw, int K, int Ndst, bf16* WT, LAS float* scr, int item, int tid, const float* kg) {
    const int nblk = Ndst / 256, kb = item / nblk, nb = item % nblk, k0 = 64 * kb, r0 = 256 * nb;
    const int n4 = 4 * (tid & 63), rsub = tid >> 6;
    const int sc = MODE == 1 ? src_in(r0 + n4) : MODE == 2 ? src_ffi(r0 + n4) : r0 + n4;
    f32x4 v[8];
#pragma unroll
    for (int i = 0; i < 8; ++i) v[i] = sc >= 0 ? *(const f32x4*)(W + (size_t)(k0 + 8 * i + rsub) * ldw + sc) : (f32x4){0.f, 0.f, 0.f, 0.f};
    const float cs = (MODE == 1 && r0 + n4 >= 4096 && r0 + n4 < 7168) ? -1.4426950408889634f : 1.0f;
#pragma unroll
    for (int i = 0; i < 8; ++i) { const int kk = 8 * i + rsub; const float gk = (kg ? kg[k0 + kk] : 1.0f) * cs; LAS float* d = scr + kk * 257 + n4; d[0] = v[i].x * gk; d[1] = v[i].y * gk; d[2] = v[i].z * gk; d[3] = v[i].w * gk; }
    __syncthreads();
#pragma unroll
    for (int j = 0; j < 4; ++j) { const int idx = tid + 512 * j, nn = idx >> 3, c = idx & 7; const LAS float* sp = scr + (8 * c) * 257 + nn;
        v4u o; o.x = pk2(sp[0 * 257], sp[1 * 257]); o.y = pk2(sp[2 * 257], sp[3 * 257]); o.z = pk2(sp[4 * 257], sp[5 * 257]); o.w = pk2(sp[6 * 257], sp[7 * 257]);
        *(GAS v4u*)(WT + (size_t)(r0 + nn) * K + k0 + 8 * c) = o; }
    __syncthreads();
}
struct LayerW { const float *w_in, *w_us, *w_ua, *w_up, *w_out, *w_fi, *w_fo, *pool_w, *pool_scale, *g_n1, *g_ssd, *g_n2; };
__device__ __forceinline__ void phase_convert(Frame& F, const LayerW& W) {
    LAS float* scr = (LAS float*)(F.lds);
    constexpr int I_IN = (D / 64) * (INW_PAD / 256), I_US = (D / 64) * (D / 256), I_UA = (512 / 64) * (D / 256), I_OUT = I_US, I_FI = (D / 64) * (2 * FFH / 256), I_FO = (FFH / 64) * (D / 256);
    constexpr int NITEMS = I_IN + I_US + I_UA + I_OUT + I_FI + I_FO;
    for (int it = F.bid; it < NITEMS; it += F.G) {
        int r = it;
        if (r < I_IN) { cvt_item<1>(W.w_in, INW, D, INW_PAD, (bf16*)(F.ws + WS_WIN), scr, r, F.tid, W.g_n1); continue; } r -= I_IN;
        if (r < I_US) { cvt_item<0>(W.w_us, D, D, D, (bf16*)(F.ws + WS_WUS), scr, r, F.tid, W.g_ssd); continue; } r -= I_US;
        if (r < I_UA) { cvt_item<0>(W.w_ua, D, 1024, D, (bf16*)(F.ws + WS_WUA), scr, r, F.tid, nullptr); continue; } r -= I_UA;
        if (r < I_OUT) { cvt_item<0>(W.w_out, D, D, D, (bf16*)(F.ws + WS_WOUT), scr, r, F.tid, nullptr); continue; } r -= I_OUT;
        if (r < I_FI) { cvt_item<2>(W.w_fi, 2 * FFH, D, 2 * FFH, (bf16*)(F.ws + WS_WFI), scr, r, F.tid, W.g_n2); continue; } r -= I_FI;
        cvt_item<0>(W.w_fo, D, FFH, D, (bf16*)(F.ws + WS_WFO), scr, r, F.tid, nullptr);
    }
    bf16* WC = (bf16*)(F.ws + WS_WUA) + 512;
    LAS float* Al = (LAS float*)(F.lds); LAS float* red = (LAS float*)(F.lds + 4096);
    const bool g256 = F.G == 256;
    const int u0 = g256 ? (F.bid >= 128 ? 2 * (F.bid - 128) : 256) : F.bid, u1 = g256 ? u0 + 2 : 256, ustep = g256 ? 1 : F.G;
    for (int u = u0; u < u1 && u < 256; u += ustep) {
        const int kc0 = 4 * (u >> 1), g = kc0 >> 7, c0 = kc0 & 127, dq = F.tid >> 7, tl = F.tid & 127, n4 = (u & 1) * 512 + tl * 4;
        { const int i = F.tid >> 7, d = F.tid & 127; Al[d * 4 + i] = W.pool_w[((size_t)g * 128 + c0 + i) * 128 + d] * W.pool_scale[g * 128 + d]; }
        const float* up = W.w_up + (size_t)(g * 128 + dq * 32) * D + n4;
        f32x4 uv[32];
#pragma unroll
        for (int dd = 0; dd < 32; ++dd) uv[dd] = *(const f32x4*)(up + (size_t)dd * D);
        __syncthreads();
        f32x4 acc[4];
#pragma unroll
        for (int i = 0; i < 4; ++i) acc[i] = (f32x4){0.f, 0.f, 0.f, 0.f};
#pragma unroll
        for (int dd = 0; dd < 32; ++dd) { const f32x4 a = *(const LAS f32x4*)(Al + (dq * 32 + dd) * 4);
#pragma unroll
            for (int i = 0; i < 4; ++i) acc[i] += a[i] * uv[dd]; }
#pragma unroll
        for (int i = 0; i < 4; ++i) *(LAS f32x4*)(red + (dq * 128 + tl) * 16 + i * 4) = acc[i];
        __syncthreads();
        { const int j = F.tid >> 7; float r[4];
#pragma unroll
            for (int i = 0; i < 4; ++i) r[i] = (red[(0 * 128 + tl) * 16 + i * 4 + j] + red[(1 * 128 + tl) * 16 + i * 4 + j]) + (red[(2 * 128 + tl) * 16 + i * 4 + j] + red[(3 * 128 + tl) * 16 + i * 4 + j]);
            *(unsigned long long*)(WC + (size_t)((u & 1) * 512 + tl * 4 + j) * 1024 + kc0) = (unsigned long long)pk2(r[0], r[1]) | ((unsigned long long)pk2(r[2], r[3]) << 32); }
        __syncthreads();
    }
}
__device__ __forceinline__ void phase_prep(Frame& F, const float* __restrict__ src, bf16* __restrict__ dst, float* __restrict__ pss, int nrows) {
    const int gw = F.bid * NWAVES + F.wave, NGW = F.G * NWAVES;
    for (int m = gw; m < nrows; m += NGW) {
        const f32x4* xr = (const f32x4*)(src + (size_t)m * D) + 2 * F.lane;
        f32x4 v[4]; float s = 0.f;
#pragma unroll
        for (int j = 0; j < 2; ++j) { v[2 * j] = xr[128 * j]; v[2 * j + 1] = xr[128 * j + 1]; }
#pragma unroll
        for (int j = 0; j < 4; ++j) s += (v[j].x * v[j].x + v[j].y * v[j].y) + (v[j].z * v[j].z + v[j].w * v[j].w);
        s = wave_sum(s);
        v4u* o16 = (v4u*)(dst + (size_t)m * D) + F.lane;
#pragma unroll
        for (int j = 0; j < 2; ++j) { v4u o; o.x = pk2(v[2 * j].x, v[2 * j].y); o.y = pk2(v[2 * j].z, v[2 * j].w); o.z = pk2(v[2 * j + 1].x, v[2 * j + 1].y); o.w = pk2(v[2 * j + 1].z, v[2 * j + 1].w); o16[64 * j] = o; }
        if (F.lane < 4) pss[(size_t)m * 4 + F.lane] = F.lane == 0 ? s : 0.f;
    }
}
__device__ __forceinline__ void phase_final(Frame& F, const bf16* __restrict__ xn, const float* __restrict__ pss, const float* __restrict__ gain, float* __restrict__ out, int nrows) {
    const int gw = F.bid * NWAVES + F.wave, NGW = F.G * NWAVES;
    f32x4 g[4];
#pragma unroll
    for (int j = 0; j < 4; ++j) g[j] = ((const f32x4*)gain)[F.lane + 64 * j];
    for (int m = gw; m < nrows; m += NGW) {
        const float r = pg8::row_rstd(pss + (size_t)m * 4);
        const unsigned long long* x8 = (const unsigned long long*)(xn + (size_t)m * D) + F.lane;
        f32x4* o = (f32x4*)(out + (size_t)m * D) + F.lane;
#pragma unroll
        for (int j = 0; j < 4; ++j) { const unsigned long long v = x8[64 * j]; const unsigned lo = (unsigned)v, hi = (unsigned)(v >> 32);
            o[64 * j] = (f32x4){pg8::bf_lo(lo), pg8::bf_hi(lo), pg8::bf_lo(hi), pg8::bf_hi(hi)} * r * g[j]; }
    }
}
__device__ __forceinline__ void unpack8(const v4u x, float (&f)[8]) { f[0] = pg8::bf_lo(x.x); f[1] = pg8::bf_hi(x.x); f[2] = pg8::bf_lo(x.y); f[3] = pg8::bf_hi(x.y); f[4] = pg8::bf_lo(x.z); f[5] = pg8::bf_hi(x.z); f[6] = pg8::bf_lo(x.w); f[7] = pg8::bf_hi(x.w); }
__device__ __forceinline__ int ssd_place(int u, int G) { if (G != 256 || u >= 256) return u; const int x = u & 7, r = u >> 3; return ((x * 8 + (r >> 2)) << 2) | (r & 3); }
__device__ __forceinline__ void phase_conv_own(Frame& F, const float* conv_w, const float* conv_b) {
    const bf16* __restrict__ XBC = (const bf16*)(F.ws + WS_XBC); bf16* __restrict__ XBCC = (bf16*)(F.ws + WS_XBCC);
    for (int uu = F.bid; uu < NBP * 64; uu += F.G) {
        const int u = ssd_place(uu, F.G), b_loc = u >> 6, ch = (u >> 1) & 31, g = u & 1;
        for (int it = F.tid; it < 8 * 96; it += NWAVES * 64) {
            const int blk = it / 96, cg = it % 96, c = cg < 64 ? g * 512 + cg * 8 : cg < 80 ? 1024 + g * 128 + (cg - 64) * 8 : 1280 + g * 128 + (cg - 80) * 8;
            const int t0 = ch * 128 + blk * 16, r0 = b_loc * T + t0;
            float w[4][8], bs[8];
#pragma unroll
            for (int k = 0; k < 4; ++k) { const f32x4 a = *(const f32x4*)(conv_w + k * 1536 + c), b = *(const f32x4*)(conv_w + k * 1536 + c + 4);
                w[k][0] = a.x; w[k][1] = a.y; w[k][2] = a.z; w[k][3] = a.w; w[k][4] = b.x; w[k][5] = b.y; w[k][6] = b.z; w[k][7] = b.w; }
            { const f32x4 a = *(const f32x4*)(conv_b + c), b = *(const f32x4*)(conv_b + c + 4); bs[0] = a.x; bs[1] = a.y; bs[2] = a.z; bs[3] = a.w; bs[4] = b.x; bs[5] = b.y; bs[6] = b.z; bs[7] = b.w; }
            v4u xr[19];
#pragma unroll
            for (int j = 0; j < 19; ++j) xr[j] = (j >= 3 || t0 > 0) ? *(const v4u*)(XBC + (size_t)(r0 - 3 + j) * 1536 + c) : (v4u){0u, 0u, 0u, 0u};
            float x0[8], x1[8], x2[8], x3[8];
            unpack8(xr[0], x0); unpack8(xr[1], x1); unpack8(xr[2], x2);
#pragma unroll
            for (int j = 0; j < 16; ++j) {
                unpack8(xr[j + 3], x3);
                float a[8];
#pragma unroll
                for (int i = 0; i < 8; ++i) a[i] = silu_f(bs[i] + w[0][i] * x0[i] + w[1][i] * x1[i] + w[2][i] * x2[i] + w[3][i] * x3[i]);
                v4u o; o.x = pk2(a[0], a[1]); o.y = pk2(a[2], a[3]); o.z = pk2(a[4], a[5]); o.w = pk2(a[6], a[7]);
                *(v4u*)(XBCC + (size_t)(r0 + j) * 1536 + c) = o;
#pragma unroll
                for (int i = 0; i < 8; ++i) { x0[i] = x1[i]; x1[i] = x2[i]; x2[i] = x3[i]; }
            }
        }
    }
}
template <int WIN, int NT> __device__ __forceinline__ void pool_item(const bf16* __restrict__ U, bf16* __restrict__ PO, int r0, int t0, int c) {
    v4u pre[WIN - 1], cur[NT];
#pragma unroll
    for (int i = 0; i < WIN - 1; ++i) pre[i] = (t0 - (WIN - 1) + i >= 0) ? *(const v4u*)(U + (size_t)(r0 - (WIN - 1) + i) * 512 + c) : (v4u){0u, 0u, 0u, 0u};
#pragma unroll
    for (int j = 0; j < NT; ++j) cur[j] = *(const v4u*)(U + (size_t)(r0 + j) * 512 + c);
    float s[8];
#pragma unroll
    for (int i = 0; i < 8; ++i) s[i] = 0.f;
#pragma unroll
    for (int i = 0; i < WIN - 1; ++i) { float f[8]; unpack8(pre[i], f);
#pragma unroll
        for (int k = 0; k < 8; ++k) s[k] += f[k]; }
#pragma unroll
    for (int j = 0; j < NT; ++j) {
        const int t = t0 + j, cnt = (t + 1) < WIN ? (t + 1) : WIN; const float ic = __builtin_amdgcn_rcpf((float)cnt);
        float f[8]; unpack8(cur[j], f);
#pragma unroll
        for (int k = 0; k < 8; ++k) s[k] += f[k];
        v4u o; o.x = pk2(s[0] * ic - f[0], s[1] * ic - f[1]); o.y = pk2(s[2] * ic - f[2], s[3] * ic - f[3]); o.z = pk2(s[4] * ic - f[4], s[5] * ic - f[5]); o.w = pk2(s[6] * ic - f[6], s[7] * ic - f[7]);
        *(v4u*)(PO + (size_t)(r0 + j) * 1024 + c) = o;
        float g[8]; unpack8(j - WIN + 1 >= 0 ? cur[j - WIN + 1 >= 0 ? j - WIN + 1 : 0] : pre[j < WIN - 1 ? j : 0], g);
#pragma unroll
        for (int k = 0; k < 8; ++k) s[k] -= g[k];
    }
}
__device__ __forceinline__ void phase_pool(Frame& F) {
    const bf16* __restrict__ U = (const bf16*)(F.ws + WS_U); bf16* __restrict__ PO = (bf16*)(F.ws + WS_YAP) + 512;
    if (F.wave < 4) return;
    const int grp = F.wave - 4, coct = F.lane & 15, bsub = F.lane >> 4, c = grp * 128 + coct * 8;
    for (int bq0 = F.bid; bq0 < MP / 64; bq0 += F.G) {
        const int bq = ssd_place(bq0, F.G), blk = bq * 4 + bsub, r0 = blk * 16, t0 = r0 & (T - 1);
        if (grp == 0) pool_item<2, 16>(U, PO, r0, t0, c); else if (grp == 1) pool_item<4, 16>(U, PO, r0, t0, c); else if (grp == 2) pool_item<8, 16>(U, PO, r0, t0, c);
        else { pool_item<16, 8>(U, PO, r0, t0, c); pool_item<16, 8>(U, PO, r0 + 8, t0 + 8, c); }
    }
}
template <int CTRL> __device__ __forceinline__ int dpp0(int v) { return __builtin_amdgcn_update_dpp(0, v, CTRL, 0xf, 0xf, true); }
__device__ __forceinline__ unsigned wave_umax(unsigned v) {
    v = max(v, (unsigned)dpp0<0xB1>((int)v)); v = max(v, (unsigned)dpp0<0x4E>((int)v)); v = max(v, (unsigned)dpp0<0x141>((int)v)); v = max(v, (unsigned)dpp0<0x140>((int)v));
    return max(max((unsigned)__builtin_amdgcn_readlane((int)v, 0), (unsigned)__builtin_amdgcn_readlane((int)v, 16)), max((unsigned)__builtin_amdgcn_readlane((int)v, 32), (unsigned)__builtin_amdgcn_readlane((int)v, 48)));
}
__device__ __forceinline__ unsigned wave_umin(unsigned v) { return ~wave_umax(~v); }
__device__ __forceinline__ int wave_suffix_sum(int x, int lane) {
    int p = x; p += dpp0<0x111>(p); p += dpp0<0x112>(p); p += dpp0<0x114>(p); p += dpp0<0x118>(p);
    const int t0 = __builtin_amdgcn_readlane(p, 15), t1 = __builtin_amdgcn_readlane(p, 31), t2 = __builtin_amdgcn_readlane(p, 47), t3 = __builtin_amdgcn_readlane(p, 63);
    const int r = lane >> 4, trow = r == 0 ? t0 : r == 1 ? t1 : r == 2 ? t2 : t3, tabove = r == 0 ? t1 + t2 + t3 : r == 1 ? t2 + t3 : r == 2 ? t3 : 0;
    return trow - p + x + tabove;
}
__device__ __forceinline__ unsigned f2key(float f) { const unsigned u = __float_as_uint(f); return (u & 0x80000000u) ? ~u : (u | 0x80000000u); }
__device__ __forceinline__ int mbcnt64(unsigned long long m) { return (int)__builtin_amdgcn_mbcnt_hi((unsigned)(m >> 32), __builtin_amdgcn_mbcnt_lo((unsigned)m, 0u)); }
typedef float f32x16 __attribute__((ext_vector_type(16)));
struct DsaQ { bf16x8 aq[4]; };
__device__ __forceinline__ void dsa_load_q(Frame& F, int b_loc, int t0, DsaQ& Qn) {
    int lane_ = F.lane; asm volatile("" : "+v"(lane_)); const int lane = lane_;
    const bf16* QI = (const bf16*)(F.ws + WS_QI);
    const size_t rowb = (size_t)b_loc * T; const int r = lane & 31, hh = lane >> 5;
#pragma unroll
    for (int s = 0; s < 4; ++s) Qn.aq[s] = *(const bf16x8*)(QI + (rowb + t0 + (r >> 2)) * 256 + (r & 3) * 64 + 16 * s + 8 * hh);
}
__device__ __forceinline__ void dsa_scores(Frame& F, int b_loc, int t0, const DsaQ& Qc) {
    int lane_ = F.lane; asm volatile("" : "+v"(lane_)); const int lane = lane_;
    const size_t rowb = (size_t)b_loc * T;
    const int r = lane & 31, hh = lane >> 5;
    bf16x8 aq[4];
#pragma unroll
    for (int s = 0; s < 4; ++s) aq[s] = Qc.aq[s];
    float wq[4][4];
#pragma unroll
    for (int a = 0; a < 4; ++a) { const uint2 wr = *(const uint2*)((const bf16*)(F.ws + WS_MISC) + (F.prow + rowb + t0 + 2 * a + hh) * 256 + 80);
        wq[a][0] = pg8::bf_lo(wr.x) * 0.0625f; wq[a][1] = pg8::bf_hi(wr.x) * 0.0625f; wq[a][2] = pg8::bf_lo(wr.y) * 0.0625f; wq[a][3] = pg8::bf_hi(wr.y) * 0.0625f; }
    const int ntile = 2 * ((t0 + 8 + 63) >> 6);
    const bf16* KI = (const bf16*)(F.ws + WS_KI) + (F.prow + rowb + r) * 64 + 8 * hh;
    bf16x8 kb[4][4];
#define DSA_KBLOAD(j, tile_) do { _Pragma("unroll") for (int s = 0; s < 4; ++s) kb[j][s] = *(const bf16x8*)(KI + (size_t)(tile_) * 32 * 64 + 16 * s); } while (0)
#define DSA_TILE(j, tile_) do { const int key = (tile_) * 32 + r; f32x16 acc; _Pragma("unroll") for (int i = 0; i < 16; ++i) acc[i] = 0.f; \
        _Pragma("unroll") for (int s = 0; s < 4; ++s) acc = __builtin_amdgcn_mfma_f32_32x32x16_bf16(aq[s], kb[j][s], acc, 0, 0, 0); \
        if ((tile_) + 4 * NWAVES < ntile) DSA_KBLOAD(j, (tile_) + 4 * NWAVES); \
          \
        _Pragma("unroll") for (int a = 0; a < 4; ++a) { \
            const float sc = fmaxf(acc[4 * a + 0], 0.f) * wq[a][0] + fmaxf(acc[4 * a + 1], 0.f) * wq[a][1] + fmaxf(acc[4 * a + 2], 0.f) * wq[a][2] + fmaxf(acc[4 * a + 3], 0.f) * wq[a][3]; \
            ((LAS unsigned*)(F.lds + (2 * a + hh) * 16384))[key] = key <= t0 + 2 * a + hh ? f2key(sc) : 0u; } } while (0)
#pragma unroll
    for (int j = 0; j < 4; ++j) if ((int)F.wave + j * NWAVES < ntile) DSA_KBLOAD(j, F.wave + j * NWAVES);
    for (int tile = F.wave; tile < ntile; tile += 4 * NWAVES) {
        DSA_TILE(0, tile);
        if (tile + NWAVES < ntile) DSA_TILE(1, tile + NWAVES);
        if (tile + 2 * NWAVES < ntile) DSA_TILE(2, tile + 2 * NWAVES);
        if (tile + 3 * NWAVES < ntile) DSA_TILE(3, tile + 3 * NWAVES);
    }
#undef DSA_TILE
#undef DSA_KBLOAD
}
__device__ __forceinline__ void dsa_query(Frame& F, int b_loc, int t, bf16* YO) {
    int lane_ = F.lane; asm volatile("" : "+v"(lane_)); const int lane = lane_;
    LAS unsigned* srow = (LAS unsigned*)(F.lds + F.wave * 16384);
    LAS float* qs = (LAS float*)(F.lds + DSA_X_OFF + F.wave * 1024);
    LAS unsigned short* idxs = (LAS unsigned short*)(F.lds + DSA_X_OFF + 8 * 1024 + F.wave * 512);
    const bf16* KV = (const bf16*)(F.ws + WS_KV); const bf16* Q = (const bf16*)(F.ws + WS_Q);
    const size_t rowq = (size_t)b_loc * T + t, rowb = (size_t)b_loc * T;
    const int n = t + 1, k = n < 256 ? n : 256, nch = (n + 63) >> 6, npad = nch * 64;
#ifndef DSADUP
#define DSADUP 0
#endif
    unsigned thr = 0u; int need = 0;
    for (int rep_ = 0; rep_ <= ((DSADUP >> 1) & 1); ++rep_) {
    thr = 0u; need = 0;
    if (n > 256) {
        LAS unsigned* hist = (LAS unsigned*)qs;
        v4u kv[16];
#pragma unroll
        for (int i = 0; i < 16; ++i) { const int e = i * 256 + lane * 4; kv[i] = (v4u){0u, 0u, 0u, 0u}; if (i * 256 < npad) { if (e < npad) kv[i] = *(const LAS v4u*)(srow + e); } }
        unsigned kmn = 0xffffffffu, kmx = 0u;
#pragma unroll
        for (int i = 0; i < 16; ++i) if (i * 256 < npad) { const v4u v = kv[i];
            kmx = max(max(kmx, v.x), max(v.y, max(v.z, v.w)));
            kmn = min(min(kmn, v.x ? v.x : 0xffffffffu), min(v.y ? v.y : 0xffffffffu, min(v.z ? v.z : 0xffffffffu, v.w ? v.w : 0xffffffffu))); }
        kmx = wave_umax(kmx); kmn = wave_umin(kmn);
        unsigned lo = kmn; const unsigned range = kmx - kmn; unsigned win = range;
        int sh = range ? 32 - __builtin_clz(range) - 8 : 0; if (sh < 0) sh = 0;
        int krem = k;
        for (;;) {
            { v4u z4 = (v4u){0u, 0u, 0u, 0u}; asm volatile("" : "+v"(z4)); *(LAS v4u*)(hist + lane * 4) = z4; }
            WAVE_LDS_FENCE();
#pragma unroll
            for (int i = 0; i < 16; ++i) if (i * 256 < npad) { const v4u v = kv[i];
                const unsigned d0 = v.x - lo, d1 = v.y - lo, d2 = v.z - lo, d3 = v.w - lo;
                if (d0 <= win) (void)__hip_atomic_fetch_add(hist + (d0 >> sh), 1u, __ATOMIC_RELAXED, __HIP_MEMORY_SCOPE_WORKGROUP); if (d1 <= win) (void)__hip_atomic_fetch_add(hist + (d1 >> sh), 1u, __ATOMIC_RELAXED, __HIP_MEMORY_SCOPE_WORKGROUP);
                if (d2 <= win) (void)__hip_atomic_fetch_add(hist + (d2 >> sh), 1u, __ATOMIC_RELAXED, __HIP_MEMORY_SCOPE_WORKGROUP); if (d3 <= win) (void)__hip_atomic_fetch_add(hist + (d3 >> sh), 1u, __ATOMIC_RELAXED, __HIP_MEMORY_SCOPE_WORKGROUP); }
            WAVE_LDS_FENCE();
            const v4u hv = *(const LAS v4u*)(hist + lane * 4);
            const int tl = (int)(hv.x + hv.y + hv.z + hv.w); const int sfx = wave_suffix_sum(tl, lane);
            const int above = sfx - tl;
            const bool mine = above < krem && sfx >= krem;
            int bsel, babove, bcnt;
            { int c = above + (int)hv.w; if (c >= krem) { bsel = 3; babove = above; bcnt = (int)hv.w; }
              else { const int c2 = c + (int)hv.z; if (c2 >= krem) { bsel = 2; babove = c; bcnt = (int)hv.z; }
              else { const int c1 = c2 + (int)hv.y; if (c1 >= krem) { bsel = 1; babove = c2; bcnt = (int)hv.y; } else { bsel = 0; babove = c1; bcnt = (int)hv.x; } } } }
            const unsigned long long mm = __ballot(mine);
            const int src = mm ? (int)__builtin_ctzll(mm) : 0;
            const int bstar = 4 * src + __builtin_amdgcn_readlane(bsel, src), ab = __builtin_amdgcn_readlane(babove, src), cb = __builtin_amdgcn_readlane(bcnt, src);
            krem -= ab; lo += (unsigned)bstar << sh;
            if (cb == krem) { thr = lo - 1u; need = 0; break; }
            if (sh == 0) { thr = lo; need = krem; break; }
            win = (1u << sh) - 1u; sh = sh > 8 ? sh - 8 : 0;
        }
        if (need == 0) {
            int base = 0;
#pragma unroll
            for (int i = 0; i < 16; ++i) if (i * 256 < npad) { const v4u v = kv[i]; const int e = i * 256 + lane * 4;
                const bool c0 = v.x > thr, c1 = v.y > thr, c2 = v.z > thr, c3 = v.w > thr;
                const unsigned long long m0 = __ballot(c0), m1 = __ballot(c1), m2 = __ballot(c2), m3 = __ballot(c3);
                int pos = base + mbcnt64(m0) + mbcnt64(m1) + mbcnt64(m2) + mbcnt64(m3);
                if (c0) idxs[pos++] = (unsigned short)e; if (c1) idxs[pos++] = (unsigned short)(e + 1); if (c2) idxs[pos++] = (unsigned short)(e + 2); if (c3) idxs[pos] = (unsigned short)(e + 3);
                base += __builtin_popcountll(m0) + __builtin_popcountll(m1) + __builtin_popcountll(m2) + __builtin_popcountll(m3); }
        }
    }
    if (n <= 256 || need != 0) {
        int base = 0, eqseen = 0;
#pragma unroll 8
        for (int c = 0; c < nch; ++c) {
            const unsigned key = srow[c * 64 + lane]; const bool gt = key > thr, eq = key == thr;
            const unsigned long long eqm = __ballot(eq); const int eqrank = eqseen + mbcnt64(eqm);
            const bool inc = gt || (eq && eqrank < need);
            const unsigned long long im = __ballot(inc); const int pos = base + mbcnt64(im);
            if (inc) idxs[pos] = (unsigned short)(c * 64 + lane);
            base += __builtin_popcountll(im); eqseen += __builtin_popcountll(eqm);
        }
    }
    WAVE_LDS_FENCE();
    }
    for (int rep_ = ((DSADUP >> 2) & 1); rep_ >= 0; --rep_)
    {
        const int hc = lane & 15, g = lane >> 4;
        const bf16* Qr = Q + rowq * 512 + hc * 64 + 8 * g;
        const bf16x8 zf = (bf16x8){0, 0, 0, 0, 0, 0, 0, 0};
        bf16x8 bq[4];
        bq[0] = hc < 4 ? *(const bf16x8*)(Qr) : zf; bq[1] = hc < 4 ? *(const bf16x8*)(Qr + 32) : zf;
        bq[2] = (hc >= 4 && hc < 8) ? *(const bf16x8*)(Qr) : zf; bq[3] = (hc >= 4 && hc < 8) ? *(const bf16x8*)(Qr + 32) : zf;
        v4u il[8];
#pragma unroll
        for (int i = 0; i < 8; ++i) il[i] = *(const LAS v4u*)(idxs + 64 * g + 8 * i);
#define DSA_IDX(m) ((int)((((m) & 7) < 2 ? il[(m) >> 3].x : ((m) & 7) < 4 ? il[(m) >> 3].y : ((m) & 7) < 6 ? il[(m) >> 3].z : il[(m) >> 3].w) >> (16 * ((m) & 1))) & 0xffff)
        LAS unsigned char* ring = (LAS unsigned char*)srow;
#define DSA_DMA(gp, lp) __builtin_amdgcn_global_load_lds((const unsigned*)(gp), (LAS unsigned*)(lp), 16, 0, 0)
#define DSA_VMWAIT(n) asm volatile("s_waitcnt vmcnt(" #n ")" ::: "memory")
#define DSA_KISSUE(tl) do { _Pragma("unroll") for (int i = 0; i < 4; ++i) { const int ridx = 64 * g + 4 * (tl) + i < k ? DSA_IDX(4 * (tl) + i) : 0; \
            DSA_DMA(KV + (rowb + ridx) * 256 + 8 * (hc ^ (2 * ((4 * i + g) & 7))), ring + ((tl) & 3) * 4096 + i * 1024); } } while (0)
        f32x4 sc[16];
        DSA_KISSUE(0); DSA_KISSUE(1); DSA_KISSUE(2); DSA_KISSUE(3);
#pragma unroll
        for (int tl = 0; tl < 16; ++tl) {
            if (tl <= 12) DSA_VMWAIT(12); else if (tl == 13) DSA_VMWAIT(8); else if (tl == 14) DSA_VMWAIT(4); else DSA_VMWAIT(0);
            const LAS unsigned char* kt = ring + (tl & 3) * 4096 + hc * 256;
            bf16x8 ka[4];
#pragma unroll
            for (int ks = 0; ks < 4; ++ks) ka[ks] = *(const LAS bf16x8*)(kt + 16 * ((4 * ks + g) ^ (2 * (hc & 7))));
            f32x4 a = (f32x4){0.f, 0.f, 0.f, 0.f};
#pragma unroll
            for (int ks = 0; ks < 4; ++ks) a = __builtin_amdgcn_mfma_f32_16x16x32_bf16(ka[ks], bq[ks], a, 0, 0, 0);
            sc[tl] = a;
            asm volatile("s_waitcnt lgkmcnt(0)" ::: "memory");
            if (tl + 4 < 16) DSA_KISSUE(tl + 4);
        }
#undef DSA_KISSUE
#define DSA_VISSUE(c) do { _Pragma("unroll") for (int i = 0; i < 8; ++i) { const int ridx = 64 * g + 8 * (c) + i < k ? DSA_IDX(8 * (c) + i) : 0; \
            DSA_DMA(KV + (rowb + ridx) * 256 + 128 + 8 * (hc ^ (2 * ((4 * i + g) & 7))), ring + ((c) & 1) * 8192 + i * 1024); } } while (0)
        DSA_VISSUE(0); DSA_VISSUE(1);
        float mx = -INFINITY;
#pragma unroll
        for (int tl = 0; tl < 16; ++tl)
#pragma unroll
            for (int e = 0; e < 4; ++e) { const float v = (64 * e + 4 * tl + g) < k ? sc[tl][e] * 0.125f : -INFINITY; sc[tl][e] = v; mx = fmaxf(mx, v); }
        mx = pg8::xmax32(pg8::xmax16(mx));
        float sum = 0.f;
#pragma unroll
        for (int tl = 0; tl < 16; ++tl)
#pragma unroll
            for (int e = 0; e < 4; ++e) { const float p = __expf(sc[tl][e] - mx); sc[tl][e] = p; sum += p; }
        sum = pg8::xsum32(pg8::xsum16(sum));
        const float inv = 1.0f / sum;
        bf16x8 pb[8];
#pragma unroll
        for (int c = 0; c < 8; ++c) { const unsigned p0 = pk2(sc[2 * c][0], sc[2 * c][1]), p1 = pk2(sc[2 * c][2], sc[2 * c][3]), p2 = pk2(sc[2 * c + 1][0], sc[2 * c + 1][1]), p3 = pk2(sc[2 * c + 1][2], sc[2 * c + 1][3]);
            pb[c][0] = (short)(p0 & 0xffff); pb[c][1] = (short)(p0 >> 16); pb[c][2] = (short)(p1 & 0xffff); pb[c][3] = (short)(p1 >> 16);
            pb[c][4] = (short)(p2 & 0xffff); pb[c][5] = (short)(p2 >> 16); pb[c][6] = (short)(p3 & 0xffff); pb[c][7] = (short)(p3 >> 16); }
        f32x4 o[8];
#pragma unroll
        for (int mt = 0; mt < 8; ++mt) o[mt] = (f32x4){0.f, 0.f, 0.f, 0.f};
        const unsigned q4 = (lane & 15) >> 2, p4 = lane & 3;
#pragma unroll
        for (int c = 0; c < 8; ++c) {
            if (c < 7) DSA_VMWAIT(8); else DSA_VMWAIT(0);
            const LAS unsigned char* Vimg = ring + (c & 1) * 8192;
#pragma unroll
            for (int mt = 0; mt < 8; ++mt) {
                const unsigned vo = 16 * ((2 * mt + (p4 >> 1)) ^ (2 * ((4 * g + q4) & 7))) + 8 * (p4 & 1);
                const s16x4 lo4 = __builtin_amdgcn_ds_read_tr16_b64_v4i16((LAS v4i16_t*)(Vimg + (4 * g + q4) * 256 + vo));
                const s16x4 hi4 = __builtin_amdgcn_ds_read_tr16_b64_v4i16((LAS v4i16_t*)(Vimg + (16 + 4 * g + q4) * 256 + vo));
                const bf16x8 va = (bf16x8){lo4.x, lo4.y, lo4.z, lo4.w, hi4.x, hi4.y, hi4.z, hi4.w};
                o[mt] = __builtin_amdgcn_mfma_f32_16x16x32_bf16(va, pb[c], o[mt], 0, 0, 0);
            }
            asm volatile("s_waitcnt lgkmcnt(0)" ::: "memory");
            if (c + 2 < 8) DSA_VISSUE(c + 2);
        }
#undef DSA_VISSUE
#undef DSA_VMWAIT
#undef DSA_DMA
#undef DSA_IDX
        v4u ow[2];
#pragma unroll
        for (int k = 0; k < 2; ++k) { const f32x4 va = (hc < 4 ? o[2 * k] : o[4 + 2 * k]) * inv, vb = (hc < 4 ? o[2 * k + 1] : o[4 + 2 * k + 1]) * inv;
            const auto rl = __builtin_amdgcn_permlane16_swap(pk2(va[0], va[1]), pk2(vb[0], vb[1]), false, false); const auto rh = __builtin_amdgcn_permlane16_swap(pk2(va[2], va[3]), pk2(vb[2], vb[3]), false, false);
            ow[k].x = rl[0]; ow[k].y = rh[0]; ow[k].z = rl[1]; ow[k].w = rh[1]; }
        if (hc < 8) {
            bf16* op = (rep_ ? (bf16*)(F.ws + WS_STATES) : YO) + rowq * 1024 + hc * 64 + ((g & 1) ? 16 + 4 * (g - 1) : 4 * g);
#pragma unroll
            for (int k = 0; k < 2; ++k) *(v4u*)(op + 32 * k) = ow[k];
        }
    }
}
__device__ __forceinline__ void dsa_unit(Frame& F, int i, int& b_loc, int& qb) {
    const long u = (long)F.bid + (long)F.G * i; const int r = (int)(u % 512);
    b_loc = (int)(u / 512);
    const int pi = (r & 255), pm = (b_loc & 1) ? 255 - pi : pi;
    qb = r < 256 ? pm : 511 - pm;
}
__device__ __forceinline__ void phase_dsa(Frame& F, bf16* YO) {
    const int nu = (int)(((long)NBP * 512 - F.bid + F.G - 1) / F.G);
    for (int i = 0; i < nu; ++i) {
        int b_loc, qb; dsa_unit(F, i, b_loc, qb);
        __syncthreads();
        for (int rep_ = 0; rep_ <= (DSADUP & 1); ++rep_) { DsaQ Qc; dsa_load_q(F, b_loc, qb * 8, Qc); dsa_scores(F, b_loc, qb * 8, Qc); }
        __syncthreads();
        dsa_query(F, b_loc, qb * 8 + F.wave, YO);
    }
}
__device__ __forceinline__ unsigned rr16(unsigned lane, unsigned rb, unsigned s) { return ((lane & 15) + 16 * rb) * RS + 64 * s + 16 * (lane >> 4); }
__device__ __forceinline__ unsigned tr16(unsigned lane, unsigned c, unsigned ks, unsigned t) { const unsigned g = lane >> 4, q = (lane & 15) >> 2, p = lane & 3; return (32 * ks + 8 * g + 4 * t + q) * RS + (16 * c + 4 * p) * 2; }
__device__ __forceinline__ bf16x8 rowfrag(LAS unsigned char* img, unsigned lane, unsigned rb, unsigned s) { return *(const LAS bf16x8*)(img + rr16(lane, rb, s)); }
__device__ __forceinline__ bf16x8 trfrag(LAS unsigned char* img, unsigned lane, unsigned c, unsigned ks) {
    const s16x4 lo = __builtin_amdgcn_ds_read_tr16_b64_v4i16((LAS v4i16_t*)(img + tr16(lane, c, ks, 0))), hi = __builtin_amdgcn_ds_read_tr16_b64_v4i16((LAS v4i16_t*)(img + tr16(lane, c, ks, 1)));
    return (bf16x8){lo.x, lo.y, lo.z, lo.w, hi.x, hi.y, hi.z, hi.w};
}
__device__ __forceinline__ unsigned tr16p(unsigned lane, unsigned c, unsigned ks, unsigned t) { const unsigned g = lane >> 4, q = (lane & 15) >> 2, p = lane & 3; return (32 * ks + 8 * g + 4 * t + q) * RS + (32 * (c >> 1) + 8 * p + 4 * (c & 1)) * 2; }
__device__ __forceinline__ bf16x8 trfragp(LAS unsigned char* img, unsigned lane, unsigned c, unsigned ks) {
    const s16x4 lo = __builtin_amdgcn_ds_read_tr16_b64_v4i16((LAS v4i16_t*)(img + tr16p(lane, c, ks, 0))), hi = __builtin_amdgcn_ds_read_tr16_b64_v4i16((LAS v4i16_t*)(img + tr16p(lane, c, ks, 1)));
    return (bf16x8){lo.x, lo.y, lo.z, lo.w, hi.x, hi.y, hi.z, hi.w};
}
__device__ __forceinline__ float softplus_f(float x) { return x > 20.f ? x : log1pf(__expf(x)); }
__device__ __forceinline__ float ssd_tables(const bf16* MS, size_t row0, int h, float bias, float A, LAS float* acs, LAS float* dts, int lane) {
    const float dt0 = softplus_f(bf2f(MS[(row0 + 2 * lane) * 256 + 64 + h]) + bias), dt1 = softplus_f(bf2f(MS[(row0 + 2 * lane + 1) * 256 + 64 + h]) + bias);
    const float a0 = dt0 * A, a1 = dt1 * A; float s = a0 + a1;
#pragma unroll
    for (int o = 1; o < 64; o <<= 1) { const float t = __shfl_up(s, o); if (lane >= o) s += t; }
    const float ex = s - (a0 + a1);
    acs[2 * lane] = ex + a0; acs[2 * lane + 1] = ex + a0 + a1; dts[2 * lane] = dt0; dts[2 * lane + 1] = dt1;
    return __shfl(s, 63);
}
__device__ __forceinline__ void phase_ssd_states(Frame& F, const float* dt_bias, const float* a_log) {
    const bf16* XC = (const bf16*)(F.ws + WS_XBCC); const bf16* MS = (const bf16*)(F.ws + WS_MISC) + F.prow * 256; bf16* ST = (bf16*)(F.ws + WS_STATES); float* DEC = (float*)(F.ws + WS_DEC);
    const int tid = F.tid, lane = F.lane, w = F.wave;
    LAS unsigned char* Bs = F.lds;
    LAS unsigned char* Xi = F.lds + 128 * RS + (w >> 2) * (128 * RS);
    LAS float* acs = (LAS float*)(F.lds + DSA_X_OFF + w * 1024); LAS float* dts = acs + 128;
    for (int uu = F.bid; uu < NBP * 64; uu += F.G) {
        const int u = ssd_place(uu, F.G), b_loc = u >> 6, c = (u >> 1) & 31, g = u & 1, h = g * 8 + w;
        const size_t row0 = (size_t)b_loc * T + c * 128;
        const float A = -__expf(a_log[h]);
        __syncthreads();
        const float a_end = ssd_tables(MS, row0, h, dt_bias[h], A, acs, dts, lane);
#pragma unroll
        for (int i = 0; i < 4; ++i) { const int idx = tid + 512 * i, r = idx >> 4, ch = idx & 15;
            const v4u v = __builtin_nontemporal_load((const v4u*)(XC + (row0 + r) * 1536 + 1024 + g * 128 + ch * 8)); *(LAS v4u*)(Bs + r * RS + 16 * (ch)) = v; }
        asm volatile("s_waitcnt lgkmcnt(0)" ::: "memory"); __builtin_amdgcn_wave_barrier();
        bf16* sp = ST + ((size_t)((b_loc * 32 + c) * 16 + h)) * 8192;
        for (int ph = 0; ph < 2; ++ph) {
            if (ph) __syncthreads();
#pragma unroll
            for (int i = 0; i < 8; ++i) { const int idx = lane + 64 * i, r = idx >> 2, c4 = idx & 3;
                const v4u v = __builtin_nontemporal_load((const v4u*)(XC + (row0 + r) * 1536 + h * 64 + 32 * ph + c4 * 8));
                const float sc = dts[r] * __expf(a_end - acs[r]);
                v4u o; o.x = pk2(pg8::bf_lo(v.x) * sc, pg8::bf_hi(v.x) * sc); o.y = pk2(pg8::bf_lo(v.y) * sc, pg8::bf_hi(v.y) * sc); o.z = pk2(pg8::bf_lo(v.z) * sc, pg8::bf_hi(v.z) * sc); o.w = pk2(pg8::bf_lo(v.w) * sc, pg8::bf_hi(v.w) * sc);
                *(LAS v4u*)(Xi + r * RS + 16 * ((w & 3) * 4 + c4)) = o; }
            __syncthreads();
            f32x4 acc[8][2];
#pragma unroll
            for (int i = 0; i < 8; ++i) { acc[i][0] = (f32x4){0.f, 0.f, 0.f, 0.f}; acc[i][1] = (f32x4){0.f, 0.f, 0.f, 0.f}; }
#pragma unroll
            for (int ks = 0; ks < 4; ++ks) {
                const bf16x8 xb0 = trfrag(Xi, lane, (w & 3) * 2 + 0, ks), xb1 = trfrag(Xi, lane, (w & 3) * 2 + 1, ks);
#pragma unroll
                for (int i = 0; i < 8; ++i) { const bf16x8 a = trfrag(Bs, lane, i, ks);
                    acc[i][0] = __builtin_amdgcn_mfma_f32_16x16x32_bf16(a, xb0, acc[i][0], 0, 0, 0); acc[i][1] = __builtin_amdgcn_mfma_f32_16x16x32_bf16(a, xb1, acc[i][1], 0, 0, 0); }
            }
#pragma unroll
            for (int k = 0; k < 4; ++k)
#pragma unroll
                for (int j = 0; j < 2; ++j) { const int pp = 32 * ph + 16 * j + (lane & 15), g4 = lane >> 4, n = 32 * k + ((g4 & 1) ? 16 + 4 * (g4 - 1) : 4 * g4);
                    const auto rl = __builtin_amdgcn_permlane16_swap(pk2(acc[2 * k][j][0], acc[2 * k][j][1]), pk2(acc[2 * k + 1][j][0], acc[2 * k + 1][j][1]), false, false);
                    const auto rh = __builtin_amdgcn_permlane16_swap(pk2(acc[2 * k][j][2], acc[2 * k][j][3]), pk2(acc[2 * k + 1][j][2], acc[2 * k + 1][j][3]), false, false);
                    v4u o; o.x = rl[0]; o.y = rh[0]; o.z = rl[1]; o.w = rh[1];
                    *(v4u*)(sp + pp * 128 + n) = o; }
        }
        if (lane == 0) DEC[(b_loc * 32 + c) * 16 + h] = __expf(a_end);
    }
}
__device__ __forceinline__ void phase_ssd_scan(Frame& F) {
    bf16* ST = (bf16*)(F.ws + WS_STATES); const float* DEC = (const float*)(F.ws + WS_DEC);
    if (F.tid >= 256) return;
    for (int gt = F.bid * 256 + F.tid; gt < NBP * 16 * 1024; gt += F.G * 256) {
        const int bh = gt >> 10, e8 = gt & 1023, b_loc = bh >> 4, h = bh & 15;
        bf16* sp = ST + ((size_t)(b_loc * 32) * 16 + h) * 8192 + e8 * 8; const float* dp = DEC + (b_loc * 32) * 16 + h;
        float s[8];
#pragma unroll
        for (int i = 0; i < 8; ++i) s[i] = 0.f;
#pragma unroll
        for (int cb = 0; cb < 2; ++cb) {
            v4u v[16]; float d[16];
#pragma unroll
            for (int c = 0; c < 16; ++c) { v[c] = *(const v4u*)(sp + (size_t)(16 * cb + c) * 16 * 8192); d[c] = dp[(16 * cb + c) * 16]; }
#pragma unroll
            for (int c = 0; c < 16; ++c) {
                v4u o; o.x = pk2(s[0], s[1]); o.y = pk2(s[2], s[3]); o.z = pk2(s[4], s[5]); o.w = pk2(s[6], s[7]);
                *(v4u*)(sp + (size_t)(16 * cb + c) * 16 * 8192) = o;
                float f[8]; unpack8(v[c], f);
#pragma unroll
                for (int i = 0; i < 8; ++i) s[i] = s[i] * d[c] + f[i];
            }
        }
    }
}
__device__ __forceinline__ void phase_ssd_out(Frame& F, const float* dt_bias, const float* a_log, const float* d_skip, bf16* ZO) {
    const bf16* XC = (const bf16*)(F.ws + WS_XBCC); const bf16* MS = (const bf16*)(F.ws + WS_MISC) + F.prow * 256; const bf16* ST = (const bf16*)(F.ws + WS_STATES); const bf16* Z = (const bf16*)(F.ws + WS_Z); float* SSQ = (float*)(F.ws + WS_SSQ);
    const int tid = F.tid, lane = F.lane, w = F.wave;
    LAS unsigned char* Cs = F.lds;
    LAS unsigned char* Bs = F.lds + 128 * RS;
    LAS unsigned char* Xi = F.lds + 256 * RS + (w >> 1) * (64 * RS);
    static_assert(256 * RS + 4 * 64 * RS <= DSA_X_OFF, "SSD LDS map");
    LAS float* acs = (LAS float*)(F.lds + DSA_X_OFF + w * 1024); LAS float* dts = acs + 128;
    LAS float* sqp = (LAS float*)(F.lds + DSA_X_OFF + 8192);
    for (int uu = F.bid; uu < NBP * 64; uu += F.G) {
        const int u = ssd_place(uu, F.G), b_loc = u >> 6, c = (u >> 1) & 31, g = u & 1, h = g * 8 + w;
        const size_t row0 = (size_t)b_loc * T + c * 128;
        const float A = -__expf(a_log[h]), Dh = d_skip[h];
        __syncthreads();
        (void)ssd_tables(MS, row0, h, dt_bias[h], A, acs, dts, lane);
#pragma unroll
        for (int i = 0; i < 4; ++i) { const int idx = tid + 512 * i, r = idx >> 4, ch = idx & 15; const bf16* rp = XC + (row0 + r) * 1536 + g * 128 + ch * 8;
            const v4u vb = *(const v4u*)(rp + 1024), vc = *(const v4u*)(rp + 1280); *(LAS v4u*)(Bs + r * RS + 16 * (ch)) = vb; *(LAS v4u*)(Cs + r * RS + 16 * (ch)) = vc; }
        asm volatile("s_waitcnt lgkmcnt(0)" ::: "memory"); __builtin_amdgcn_wave_barrier();
#pragma unroll
        for (int i = 0; i < 8; ++i) { const int idx = lane + 64 * i, r = idx >> 3, c8 = idx & 7;
            const v4u v = *(const v4u*)(XC + (row0 + r) * 1536 + h * 64 + c8 * 8); const float sc = dts[r];
            v4u o; o.x = pk2(pg8::bf_lo(v.x) * sc, pg8::bf_hi(v.x) * sc); o.y = pk2(pg8::bf_lo(v.y) * sc, pg8::bf_hi(v.y) * sc); o.z = pk2(pg8::bf_lo(v.z) * sc, pg8::bf_hi(v.z) * sc); o.w = pk2(pg8::bf_lo(v.w) * sc, pg8::bf_hi(v.w) * sc);
            *(LAS v4u*)(Xi + r * RS + 16 * ((w & 1) * 8 + c8)) = o; }
        __syncthreads();
        {
            f32x4 cb[8];
#pragma unroll
            for (int i = 0; i < 8; ++i) cb[i] = (f32x4){0.f, 0.f, 0.f, 0.f};
#pragma unroll
            for (int ks = 0; ks < 4; ++ks) { const bf16x8 a = rowfrag(Bs, lane, w, ks);
#pragma unroll
                for (int i = 0; i < 8; ++i) if (i >= w) cb[i] = __builtin_amdgcn_mfma_f32_16x16x32_bf16(a, rowfrag(Cs, lane, i, ks), cb[i], 0, 0, 0); }
            __syncthreads();
#pragma unroll
            for (int i = 0; i < 8; ++i) if (i >= w) { const unsigned l = 16 * i + (lane & 15);
                *(LAS unsigned long long*)(Bs + l * RS + (16 * w + 4 * (lane >> 4)) * 2) = (unsigned long long)pk2(cb[i][0], cb[i][1]) | ((unsigned long long)pk2(cb[i][2], cb[i][3]) << 32); }
            __syncthreads();
        }
        LAS unsigned char* CB = Bs;
        const bf16* pv = ST + ((size_t)((b_loc * 32 + c) * 16 + h)) * 8192 + (lane & 15) * 128 + 8 * (lane >> 4);
        for (int hl = 0; hl < 2; ++hl) {
            f32x4 acc[4][4];
#pragma unroll
            for (int j = 0; j < 4; ++j)
#pragma unroll
                for (int ii = 0; ii < 4; ++ii) acc[j][ii] = (f32x4){0.f, 0.f, 0.f, 0.f};
#pragma unroll 1
            for (int ks = 0; ks < 4; ++ks) {
                bf16x8 pa[4];
#pragma unroll
                for (int j = 0; j < 4; ++j) pa[j] = *(const bf16x8*)(pv + j * 16 * 128 + 32 * ks);
#pragma unroll
                for (int ii = 0; ii < 4; ++ii) { const bf16x8 cf = rowfrag(Cs, lane, 4 * hl + ii, ks);
#pragma unroll
                    for (int j = 0; j < 4; ++j) acc[j][ii] = __builtin_amdgcn_mfma_f32_16x16x32_bf16(pa[j], cf, acc[j][ii], 0, 0, 0); }
            }
#pragma unroll
            for (int ii = 0; ii < 4; ++ii) { const float el = __expf(acs[16 * (4 * hl + ii) + (lane & 15)]);
#pragma unroll
                for (int j = 0; j < 4; ++j) acc[j][ii] = acc[j][ii] * el; }
#pragma unroll 1
            for (int ks = 0; ks < 2 + 2 * hl; ++ks) {
                {
                    if (ks == 2) {
                        __syncthreads();
#pragma unroll
                        for (int i = 0; i < 8; ++i) { const int idx = lane + 64 * i, r = idx >> 3, c8 = idx & 7;
                            const v4u v = *(const v4u*)(XC + (row0 + 64 + r) * 1536 + h * 64 + c8 * 8); const float sc = dts[64 + r];
                            v4u o; o.x = pk2(pg8::bf_lo(v.x) * sc, pg8::bf_hi(v.x) * sc); o.y = pk2(pg8::bf_lo(v.y) * sc, pg8::bf_hi(v.y) * sc); o.z = pk2(pg8::bf_lo(v.z) * sc, pg8::bf_hi(v.z) * sc); o.w = pk2(pg8::bf_lo(v.w) * sc, pg8::bf_hi(v.w) * sc);
                            *(LAS v4u*)(Xi + r * RS + 16 * ((w & 1) * 8 + c8)) = o; }
                        __syncthreads();
                    }
                    bf16x8 xa[4];
#pragma unroll
                    for (int j = 0; j < 4; ++j) xa[j] = trfrag(Xi, lane, (w & 1) * 4 + j, ks & 1);
                    const int s0 = 32 * ks + 8 * (lane >> 4);
                    const f32x4 as0 = *(const LAS f32x4*)(acs + s0), as1 = *(const LAS f32x4*)(acs + s0 + 4);
#pragma unroll
                    for (int ii = 0; ii < 4; ++ii) if (4 * hl + ii >= 2 * ks) {
                        const int l = 16 * (4 * hl + ii) + (lane & 15);
                        const bf16x8 cbv = rowfrag(CB, lane, 4 * hl + ii, ks);
                        const float al = acs[l], dd = Dh * __builtin_amdgcn_rcpf(dts[l]);
                        float m[8];
                        m[0] = bf2f((unsigned short)cbv[0]) * __expf(al - as0.x); m[1] = bf2f((unsigned short)cbv[1]) * __expf(al - as0.y); m[2] = bf2f((unsigned short)cbv[2]) * __expf(al - as0.z); m[3] = bf2f((unsigned short)cbv[3]) * __expf(al - as0.w);
                        m[4] = bf2f((unsigned short)cbv[4]) * __expf(al - as1.x); m[5] = bf2f((unsigned short)cbv[5]) * __expf(al - as1.y); m[6] = bf2f((unsigned short)cbv[6]) * __expf(al - as1.z); m[7] = bf2f((unsigned short)cbv[7]) * __expf(al - as1.w);
#pragma unroll
                        for (int jj = 0; jj < 8; ++jj) { const int sx = s0 + jj; m[jj] = sx < l ? m[jj] : (sx == l ? m[jj] + dd : 0.f); }
                        bf16x8 mf; { const unsigned p0 = pk2(m[0], m[1]), p1 = pk2(m[2], m[3]), p2 = pk2(m[4], m[5]), p3 = pk2(m[6], m[7]);
                            mf[0] = (short)(p0 & 0xffff); mf[1] = (short)(p0 >> 16); mf[2] = (short)(p1 & 0xffff); mf[3] = (short)(p1 >> 16); mf[4] = (short)(p2 & 0xffff); mf[5] = (short)(p2 >> 16); mf[6] = (short)(p3 & 0xffff); mf[7] = (short)(p3 >> 16); }
#pragma unroll
                        for (int j = 0; j < 4; ++j) acc[j][ii] = __builtin_amdgcn_mfma_f32_16x16x32_bf16(xa[j], mf, acc[j][ii], 0, 0, 0);
                    }
                }
            }
            unsigned long long zq[4][4];
#pragma unroll
            for (int ii = 0; ii < 4; ++ii)
#pragma unroll
                for (int j = 0; j < 4; ++j) zq[ii][j] = *(const unsigned long long*)(Z + (row0 + 16 * (4 * hl + ii) + (lane & 15)) * 1024 + h * 64 + 16 * j + 4 * (lane >> 4));
#pragma unroll
            for (int ii = 0; ii < 4; ++ii) { float q = 0.f;
#pragma unroll
                for (int jp = 0; jp < 2; ++jp) { unsigned pl[2], ph2[2];
#pragma unroll
                    for (int jj = 0; jj < 2; ++jj) { const int j = 2 * jp + jj;
                        const unsigned long long zv = zq[ii][j]; const unsigned zl = (unsigned)zv, zh = (unsigned)(zv >> 32);
                        const float g0 = acc[j][ii][0] * silu_f(pg8::bf_lo(zl)), g1 = acc[j][ii][1] * silu_f(pg8::bf_hi(zl)), g2 = acc[j][ii][2] * silu_f(pg8::bf_lo(zh)), g3 = acc[j][ii][3] * silu_f(pg8::bf_hi(zh));
                        q += (g0 * g0 + g1 * g1) + (g2 * g2 + g3 * g3);
                        pl[jj] = pk2(g0, g1); ph2[jj] = pk2(g2, g3); }
                    const auto rl = __builtin_amdgcn_permlane16_swap(pl[0], pl[1], false, false); const auto rh = __builtin_amdgcn_permlane16_swap(ph2[0], ph2[1], false, false);
                    const int g4 = lane >> 4; const size_t zi = (row0 + 16 * (4 * hl + ii) + (lane & 15)) * 1024 + h * 64 + 32 * jp + ((g4 & 1) ? 16 + 4 * (g4 - 1) : 4 * g4);
                    v4u o; o.x = rl[0]; o.y = rh[0]; o.z = rl[1]; o.w = rh[1];
                    *(v4u*)(ZO + zi) = o; }
                q = pg8::xsum32(pg8::xsum16(q));
                if (lane < 16) sqp[(16 * (4 * hl + ii) + lane) * 8 + w] = q; }
        }
        __syncthreads();
        if (tid < 128) { const f32x4 q0 = *(const LAS f32x4*)(sqp + tid * 8), q1 = *(const LAS f32x4*)(sqp + tid * 8 + 4); SSQ[(row0 + tid) * 2 + g] = ((q0.x + q0.y) + (q0.z + q0.w)) + ((q1.x + q1.y) + (q1.z + q1.w)); }
    }
}
struct Args { const float* in[19]; float* out; unsigned char* ws; int lo, hi; };
static_assert(sizeof(Args) == 21 * 8 + 8, "Args has no holes");
#define CAS __attribute__((address_space(4)))
struct ProjOrder {
    pg8::StaticOrder S; int extra;
    __device__ __forceinline__ void init(int G, int c, int extra_) { S.init(MP, 28 * 256, G, c); extra = extra_; }
    __device__ __forceinline__ bool next(int i, pg8::Unit& u) const {
        const long Lx = (long)i * S.G + S.c;
        if (Lx < S.nwg) return S.next(i, u);
        if (Lx >= S.nwg + extra) return false;
        u.pm = (int)(Lx - S.nwg); u.pn = 28; return true;
    }
    __device__ __forceinline__ void a_ready(const pg8::Unit&) const {}
    __device__ __forceinline__ void done(const pg8::Unit&) const {}
};
struct MergeOrder {
    pg8::StaticOrder S; const char *A0, *A1, *B0, *B1;
    __device__ __forceinline__ bool next(int i, pg8::Unit& u) const { if (!S.next(i / 3, u)) return false; u.br = i % 3; return true; }
    __device__ __forceinline__ int nt(const pg8::Unit& u) const { return u.br == 0 ? 16 : 8; }
    __device__ __forceinline__ const char* abase(const pg8::Unit& u) const { return u.br == 0 ? A0 : A1 + (u.br - 1) * 1024; }
    __device__ __forceinline__ const char* bbase(const pg8::Unit& u) const { return u.br == 0 ? B0 : B1 + (u.br - 1) * 1024; }
    __device__ __forceinline__ bool fresh(const pg8::Unit& u) const { return u.br == 0; }
    __device__ __forceinline__ void a_ready(const pg8::Unit&) const {}
    __device__ __forceinline__ void done(const pg8::Unit&) const {}
};
template <class Sched> __device__ __forceinline__ pg8::RstdTab make_rstd_tab(const Sched& S, const float* pss, LAS unsigned char* lds, int tid) {
    LAS float* tab = (LAS float*)(lds + DSA_X_OFF + 4096);
    int pmA = -1, pmB = -1; pg8::Unit u;
    for (int i = 0; S.next(i, u); ++i) { if (pmA < 0) pmA = u.pm; else if (u.pm != pmA && pmB < 0) pmB = u.pm; }
    const int pmT = tid < 256 ? pmA : pmB;
    if (pmT >= 0) tab[tid] = pg8::row_rstd(pss + (size_t)(pmT * 256 + (tid & 255)) * 4);
    __syncthreads();
    return pg8::RstdTab{tab, pmA, pmB, pss};
}
__device__ __forceinline__ const CAS Args* kargs() { const CAS Args* p = (const CAS Args*)__builtin_amdgcn_kernarg_segment_ptr(); asm volatile("" : "+s"(p)); return p; }
__device__ __forceinline__ Frame mkframe(const CAS Args* A, LAS unsigned char* lds) {
    Frame F; F.lds = lds; F.MISC = (volatile LAS unsigned*)(lds + MISC_OFF);
    int t_ = threadIdx.x; asm volatile("" : "+v"(t_));
    F.tid = t_; F.lane = t_ & 63; F.wave = __builtin_amdgcn_readfirstlane(t_ >> 6);
    F.G = gridDim.x; F.bid = blockIdx.x; F.ws = A->ws; F.ctl = (gu32*)(F.ws + WS_CTL); F.prow = 0;
    return F;
}
__global__ void __launch_bounds__(NWAVES * 64, 2) trunk_fwd(Args args) {
    extern __shared__ __attribute__((aligned(16))) unsigned char lds[];
    LAS unsigned char* const L = (LAS unsigned char*)lds;
    for (int u = threadIdx.x; u < (LDS_BYTES - LDSCTL_OFF) / 4; u += NWAVES * 64) ((LAS unsigned*)(L + LDSCTL_OFF))[u] = 0u;
    __syncthreads();
    { const CAS Args* A = kargs(); (void)xcd_barrier_post((unsigned*)(A->ws + WS_CTL) + 4096, (volatile LAS unsigned*)(L + MISC_OFF) + 8); }
    const int lo = args.lo, hi = args.hi;
#ifndef PHASE_MASK
#define PHASE_MASK 0x7ff
#endif
#define PH(k) (((PHASE_MASK) >> (k)) & 1)
#ifndef DUP_MASK
#define DUP_MASK 0
#endif
#define DUP(k) (((DUP_MASK) >> (k)) & 1)
#define RUN(s) (lo <= (s) && (s) < hi)
#define SEAM_ALWAYS() do { const CAS Args* A_ = kargs(); XcdBarrier bar_; bar_.bar = (unsigned*)(A_->ws + WS_CTL) + 4096; bar_.x = xb_xcc_id(); bar_.st = (volatile LAS unsigned*)(L + MISC_OFF) + 8; xcd_barrier(bar_); if (DUP(12)) xcd_barrier(bar_); } while (0)
#define SEAM(s) do { if (RUN(s) && RUN((s) + 1)) { const CAS Args* A_ = kargs(); XcdBarrier bar_; bar_.bar = (unsigned*)(A_->ws + WS_CTL) + 4096; bar_.x = xb_xcc_id(); bar_.st = (volatile LAS unsigned*)(L + MISC_OFF) + 8; xcd_barrier(bar_); if (DUP(12)) xcd_barrier(bar_); } } while (0)
    for (int l = 0; l < NL; ++l) {
        const int sb = l * 13;
        if (PH(0) && RUN(sb)) {
            const CAS Args* A = kargs(); Frame F = mkframe(A, L);
            LayerW W; W.w_in = A->in[2] + (size_t)l * D * INW; W.w_us = A->in[11] + (size_t)l * D * D; W.w_ua = A->in[12] + (size_t)l * 512 * D; W.w_up = A->in[13] + (size_t)l * 512 * D;
            W.w_out = A->in[14] + (size_t)l * D * D; W.w_fi = A->in[16] + (size_t)l * D * 2 * FFH; W.w_fo = A->in[17] + (size_t)l * FFH * D; W.pool_w = A->in[9] + (size_t)l * 4 * 128 * 128; W.pool_scale = A->in[10] + (size_t)l * 512; W.g_n1 = A->in[1] + (size_t)l * D; W.g_ssd = A->in[8] + (size_t)l * D; W.g_n2 = A->in[15] + (size_t)l * D;
            for (int rep = 0; rep <= DUP(0); ++rep) {
            phase_convert(F, W);
            if (l == 0) phase_prep(F, A->in[0], (bf16*)(F.ws + WS_XN), (float*)(F.ws + WS_PSS), M); }
        }
        SEAM(sb);
        for (int p = 0; p < NPASS; ++p) {
            const int s1 = sb + 1 + p * 5;
            if (PH(1) && RUN(s1)) {
                const CAS Args* A = kargs(); Frame F = mkframe(A, L); unsigned char* ws = F.ws;
                pg8::Gemm g{(const bf16*)(ws + WS_XN) + (size_t)p * MP * D, (const bf16*)(ws + WS_WIN), MP, INW_PAD, D}; ProjOrder S; S.init(F.G, F.bid, p == 0 ? M / 256 : 0);
                pg8::EpiProj E{ws, make_rstd_tab(S, (const float*)(ws + WS_PSS) + (size_t)p * MP * 4, F.lds, F.tid)};
                for (int rep = 0; rep <= DUP(1); ++rep) pg8::gemm_phase<pg8::EpiProj, ProjOrder, true, true>(F.lds, g, S, E);
            }
            SEAM(s1);
            if (PH(2) && RUN(s1 + 1)) {
                const CAS Args* A = kargs(); Frame F = mkframe(A, L); F.prow = (size_t)p * MP;
                phase_conv_own(F, A->in[3] + (size_t)l * 4 * 1536, A->in[4] + (size_t)l * 1536); phase_pool(F);
                phase_dsa(F, (bf16*)(F.ws + WS_YAP));
                asm volatile("s_waitcnt vmcnt(0)" ::: "memory"); __syncthreads();
                phase_ssd_states(F, A->in[5] + l * 16, A->in[6] + l * 16);
            }
            SEAM(s1 + 1);
#ifndef SSD_NAIVE
#ifndef SSDSUB
#define SSDSUB 7
#endif
            if (PH(3) && RUN(s1 + 2)) for (int rep = DUP(3); rep >= 0; --rep) {
                if (rep != DUP(3)) SEAM_ALWAYS();
                if (SSDSUB & 2) { const CAS Args* A = kargs(); Frame F = mkframe(A, L); phase_ssd_scan(F); }
                SEAM_ALWAYS();
                for (int r2 = DUP(15); r2 >= 0; --r2) { if (r2 != DUP(15)) SEAM_ALWAYS(); if (SSDSUB & 4) { const CAS Args* A = kargs(); Frame F = mkframe(A, L); F.prow = (size_t)p * MP; phase_ssd_out(F, A->in[5] + l * 16, A->in[6] + l * 16, A->in[7] + l * 16, (bf16*)(F.ws + ((rep || r2) ? WS_MERGED : WS_Z))); } }
            }
#endif
            SEAM(s1 + 2);
#ifndef MSUB
#define MSUB 7
#endif
            if (PH(5) && RUN(s1 + 3)) for (int rep = 0; rep <= DUP(5); ++rep) {
                const CAS Args* A = kargs(); Frame F = mkframe(A, L); unsigned char* ws = F.ws;
                pg8::Gemm g{(const bf16*)(ws + WS_Z), (const bf16*)(ws + WS_WUS), MP, D, D};
                MergeOrder S; S.S.init(MP, D, F.G, F.bid); S.A0 = (const char*)(ws + WS_Z); S.A1 = (const char*)(ws + WS_YAP); S.B0 = (const char*)(ws + WS_WUS); S.B1 = (const char*)(ws + WS_WUA);
                pg8::EpiMergeChain E{(const bf16*)(ws + WS_GATES), (bf16*)(ws + WS_MERGED), (const float*)(ws + WS_SSQ)};
                pg8::gemm_phase<pg8::EpiMergeChain, MergeOrder, true, true, true>(F.lds, g, S, E);
            }
            SEAM(s1 + 3);
            if (PH(6) && RUN(s1 + 4)) {
                const CAS Args* A = kargs(); Frame F = mkframe(A, L); unsigned char* ws = F.ws;
                pg8::Gemm g{(const bf16*)(ws + WS_MERGED), (const bf16*)(ws + WS_WOUT), MP, D, D}; pg8::StaticOrder S; S.init(MP, D, F.G, F.bid);
                pg8::EpiResid E{(bf16*)(ws + WS_XN) + (size_t)p * MP * D, (float*)(ws + WS_PSS) + (size_t)p * MP * 4, (LAS float*)(F.lds + DSA_X_OFF)};
                pg8::gemm_phase<pg8::EpiResid, pg8::StaticOrder, true, true>(F.lds, g, S, E);
            }
            if (p == NPASS - 1) SEAM(s1 + 4);
        }
        if (PH(8) && RUN(sb + 11)) {
            const CAS Args* A = kargs(); Frame F = mkframe(A, L); unsigned char* ws = F.ws;
            pg8::Gemm g{(const bf16*)(ws + WS_XN), (const bf16*)(ws + WS_WFI), M, 2 * FFH, D}; pg8::StaticOrder S; S.init(M, 2 * FFH, F.G, F.bid);
            pg8::EpiSwiGLU E{(bf16*)(ws + WS_ACT), FFH, make_rstd_tab(S, (const float*)(ws + WS_PSS), F.lds, F.tid)};
            for (int rep = 0; rep <= DUP(8); ++rep) pg8::gemm_phase<pg8::EpiSwiGLU, pg8::StaticOrder, true, true>(F.lds, g, S, E);
        }
        SEAM(sb + 11);
        if (PH(9) && RUN(sb + 12)) {
            const CAS Args* A = kargs(); Frame F = mkframe(A, L); unsigned char* ws = F.ws;
            pg8::Gemm g{(const bf16*)(ws + WS_ACT), (const bf16*)(ws + WS_WFO), M, D, FFH}; pg8::StaticOrder S; S.init(M, D, F.G, F.bid);
            pg8::EpiResid E{(bf16*)(ws + WS_XN), (float*)(ws + WS_PSS), (LAS float*)(F.lds + DSA_X_OFF)};
            pg8::gemm_phase<pg8::EpiResid, pg8::StaticOrder, true, true>(F.lds, g, S, E);
        }
        SEAM(sb + 12);
    }
    if (PH(10) && RUN(NL * 13)) { const CAS Args* A = kargs(); Frame F = mkframe(A, L); phase_final(F, (const bf16*)(F.ws + WS_XN), (const float*)(F.ws + WS_PSS), A->in[18], A->out, M); }
#undef RUN
#undef SEAM
}

#ifndef N_LAUNCH_SPLIT
#define N_LAUNCH_SPLIT 0
#endif
extern "C" void kernel_launch(void* const* d_in, const int* in_sizes, int n_in, void* d_out, int out_size, void* d_ws, size_t ws_size, hipStream_t stream) {
    static int grid = 0;
    if (grid == 0) {
        if (n_in != 19 || in_sizes[0] != M * D || out_size != M * D || ws_size < WS_END) { fprintf(stderr, "kernel_launch: unexpected shapes / workspace (n_in %d, in0 %d, out %d, ws %zu); nothing launched\n", n_in, n_in > 0 ? in_sizes[0] : -1, out_size, ws_size); grid = -1; return; }
        int dev = 0, cus = 0, per_cu = 0;
        if (hipGetDevice(&dev) != hipSuccess || hipDeviceGetAttribute(&cus, hipDeviceAttributeMultiprocessorCount, dev) != hipSuccess) { grid = -1; return; }
        if (hipFuncSetAttribute((const void*)trunk_fwd, hipFuncAttributeMaxDynamicSharedMemorySize, LDS_BYTES) != hipSuccess) { fprintf(stderr, "kernel_launch: hipFuncSetAttribute failed\n"); grid = -1; return; }
        if (hipOccupancyMaxActiveBlocksPerMultiprocessor(&per_cu, (const void*)trunk_fwd, NWAVES * 64, LDS_BYTES) != hipSuccess || per_cu < 1) { fprintf(stderr, "kernel_launch: occupancy query reports %d workgroups per CU\n", per_cu); }
        (void)hipGetLastError();
        grid = cus;
    }
    if (grid < 0) return;
    if (hipMemsetAsync((char*)d_ws + WS_CTL, 0, CTL_ZERO_BYTES, stream) != hipSuccess) return;
    Args a{};
    for (int i = 0; i < 19; ++i) a.in[i] = (const float*)d_in[i];
    a.out = (float*)d_out; a.ws = (unsigned char*)d_ws;
#if N_LAUNCH_SPLIT
    for (int s = 0; s < NSTEPS; ++s) { a.lo = s; a.hi = s + 1; hipLaunchKernelGGL(trunk_fwd, dim3(grid), dim3(NWAVES * 64), LDS_BYTES, stream, a); }
#else
    a.lo = 0; a.hi = NSTEPS; hipLaunchKernelGGL(trunk_fwd, dim3(grid), dim3(NWAVES * 64), LDS_BYTES, stream, a);
#endif
}
```
